# Optimizing an MI355X kernel written in HIP

```python
import jax, jax.numpy as jnp
from jax import lax
import numpy as np

D_MODEL = 1024
BATCH = 4
SEQ = 4096
DEPTH = 1

GRID_W = 64
NA_HEADS = 8
NA_HEAD_DIM = 64
NA_WIDTH = NA_HEADS * NA_HEAD_DIM
NA_WIN_ROWS = 8
NA_WIN_COLS = 16
F_GROUPS = 4
F_GROUP_DIM = 128
F_WIDTH = F_GROUPS * F_GROUP_DIM
MEM_TOKENS = 256
MEM_HEADS = 4
MEM_HEAD_DIM = 128
MEM_WIDTH = MEM_HEADS * MEM_HEAD_DIM
N_BRANCHES = 3
D_FF = 4 * D_MODEL
IN_WIDTH = 3 * NA_WIDTH + F_WIDTH + MEM_WIDTH + N_BRANCHES * D_MODEL
EPS = 1e-6
NEG_INF = -1e30

kernel_name = "hybrid_na_fourier_memory_gated_encoder"


def rmsnorm(x, g):
    xf = x.astype(jnp.float32)
    y = xf * lax.rsqrt(jnp.mean(xf * xf, axis=-1, keepdims=True) + EPS)
    return (y * g.astype(jnp.float32)).astype(x.dtype)


def neighbourhood_attention_2d(q, k, v, rpb):
    B, S, H, d = q.shape
    rows = S // GRID_W
    wr = min(NA_WIN_ROWS, rows)
    r = jnp.arange(rows)
    rs = jnp.clip(r - wr // 2, 0, rows - wr)
    row_idx = rs[:, None] + jnp.arange(wr)[None, :]
    c = jnp.arange(GRID_W)
    cs = jnp.clip(c - NA_WIN_COLS // 2, 0, GRID_W - NA_WIN_COLS)
    kc = jnp.arange(GRID_W)
    col_valid = (kc[None, :] >= cs[:, None]) & (kc[None, :] < cs[:, None] + NA_WIN_COLS)
    dr_idx = row_idx - r[:, None] + (NA_WIN_ROWS - 1)
    dc_idx = jnp.clip(kc[None, :] - c[:, None], -(NA_WIN_COLS - 1), NA_WIN_COLS - 1) + (NA_WIN_COLS - 1)
    bias = rpb[:, dr_idx[:, None, :, None], dc_idx[None, :, None, :]]

    qg = q.reshape(B, rows, GRID_W, H, d)
    kb = k.reshape(B, rows, GRID_W, H, d)[:, row_idx]
    vb = v.reshape(B, rows, GRID_W, H, d)[:, row_idx]
    scale = 1.0 / np.sqrt(d).astype(np.float32)
    s = jnp.einsum('brchd,brwkhd->bhrcwk', qg, kb).astype(jnp.float32) * scale
    s = s + bias[None].astype(jnp.float32)
    s = jnp.where(col_valid[:, None, :], s, NEG_INF)
    p = jax.nn.softmax(s, axis=(-2, -1)).astype(v.dtype)
    o = jnp.einsum('bhrcwk,brwkhd->brchd', p, vb)
    return o.reshape(B, S, H * d)


def fourier_mix(u):
    B, S, _ = u.shape
    ug = u.reshape(B, S, F_GROUPS, F_GROUP_DIM).astype(jnp.float32)
    yf = jnp.fft.fft2(ug, axes=(1, 3), norm='ortho').real
    return yf.reshape(B, S, F_WIDTH).astype(u.dtype)


def memory_cross_attention(q, k, v):
    B, S, H, d = q.shape
    scale = 1.0 / np.sqrt(d).astype(np.float32)
    s = jnp.einsum('bshd,bmhd->bhsm', q, k).astype(jnp.float32) * scale
    p = jax.nn.softmax(s, axis=-1).astype(v.dtype)
    o = jnp.einsum('bhsm,bmhd->bshd', p, v)
    return o.reshape(B, S, H * d)


def setup_inputs(seed: int = 0) -> dict:
    key = jax.random.key(seed)
    ks = jax.random.split(key, 20)
    f32 = jnp.float32

    def w(k, shape, fan_in):
        return jax.random.normal(k, shape, f32) * (fan_in ** -0.5)

    def gain(k, n):
        return 1.0 + 0.02 * jax.random.normal(k, (n,), f32)

    return {
        "x": jax.random.normal(ks[0], (BATCH, SEQ, D_MODEL), f32),
        "mem": jax.random.normal(ks[1], (BATCH, MEM_TOKENS, D_MODEL), f32),
        "norm1_g": gain(ks[2], D_MODEL),
        "w_in": w(ks[3], (D_MODEL, IN_WIDTH), D_MODEL),
        "b_gate": 0.01 * jax.random.normal(ks[4], (N_BRANCHES * D_MODEL,), f32),
        "na_q_g": gain(ks[5], NA_HEAD_DIM),
        "na_k_g": gain(ks[6], NA_HEAD_DIM),
        "na_rpb": 0.1 * jax.random.normal(ks[7], (NA_HEADS, 2 * NA_WIN_ROWS - 1, 2 * NA_WIN_COLS - 1), f32),
        "w_na_o": w(ks[8], (NA_WIDTH, D_MODEL), NA_WIDTH),
        "w_f": w(ks[9], (F_WIDTH, D_MODEL), F_WIDTH),
        "mem_norm_g": gain(ks[10], D_MODEL),
        "w_mem_kv": w(ks[11], (D_MODEL, 2 * MEM_WIDTH), D_MODEL),
        "mem_q_g": gain(ks[12], MEM_HEAD_DIM),
        "mem_k_g": gain(ks[13], MEM_HEAD_DIM),
        "w_mem_o": w(ks[14], (MEM_WIDTH, D_MODEL), MEM_WIDTH),
        "w_out": w(ks[15], (D_MODEL, D_MODEL), D_MODEL),
        "norm2_g": gain(ks[16], D_MODEL),
        "w_ff1": w(ks[17], (D_MODEL, D_FF), D_MODEL),
        "w_ff2": w(ks[18], (D_FF, D_MODEL), D_FF),
    }


def reference(x, mem, norm1_g, w_in, b_gate, na_q_g, na_k_g, na_rpb, w_na_o, w_f,
              mem_norm_g, w_mem_kv, mem_q_g, mem_k_g, w_mem_o, w_out,
              norm2_g, w_ff1, w_ff2):
    B, S, _ = x.shape
    M = mem.shape[1]
    mem_n = rmsnorm(mem, mem_norm_g)
    mem_kv = mem_n @ w_mem_kv
    for _ in range(DEPTH):
        h = rmsnorm(x, norm1_g)
        z = h @ w_in
        o0 = 0
        na_q = z[..., o0:o0 + NA_WIDTH]; o0 += NA_WIDTH
        na_k = z[..., o0:o0 + NA_WIDTH]; o0 += NA_WIDTH
        na_v = z[..., o0:o0 + NA_WIDTH]; o0 += NA_WIDTH
        f_u = z[..., o0:o0 + F_WIDTH]; o0 += F_WIDTH
        m_q = z[..., o0:o0 + MEM_WIDTH]; o0 += MEM_WIDTH
        gates = jax.nn.sigmoid(z[..., o0:] + b_gate).reshape(B, S, N_BRANCHES, D_MODEL)

        qa = rmsnorm(na_q.reshape(B, S, NA_HEADS, NA_HEAD_DIM), na_q_g)
        ka = rmsnorm(na_k.reshape(B, S, NA_HEADS, NA_HEAD_DIM), na_k_g)
        va = na_v.reshape(B, S, NA_HEADS, NA_HEAD_DIM)
        y_na = neighbourhood_attention_2d(qa, ka, va, na_rpb) @ w_na_o

        y_f = fourier_mix(f_u) @ w_f

        qm = rmsnorm(m_q.reshape(B, S, MEM_HEADS, MEM_HEAD_DIM), mem_q_g)
        km = rmsnorm(mem_kv[..., :MEM_WIDTH].reshape(B, M, MEM_HEADS, MEM_HEAD_DIM), mem_k_g)
        vm = mem_kv[..., MEM_WIDTH:].reshape(B, M, MEM_HEADS, MEM_HEAD_DIM)
        y_mem = memory_cross_attention(qm, km, vm) @ w_mem_o

        merged = gates[:, :, 0] * y_na + gates[:, :, 1] * y_f + gates[:, :, 2] * y_mem
        x = x + merged @ w_out

        h2 = rmsnorm(x, norm2_g)
        x = x + jnp.square(jax.nn.relu(h2 @ w_ff1)) @ w_ff2
    return x
```

```cpp
#include <hip/hip_runtime.h>
#include <hip/hip_cooperative_groups.h>
#include <cstdio>
#include <cstdint>
namespace cg = cooperative_groups;

#ifndef MK_N_LAUNCHES
#define MK_N_LAUNCHES 1
#endif
#ifndef DUP_PHASE
#define DUP_PHASE -1
#endif
#define NREP(k) (((k) == DUP_PHASE) ? 2 : 1)
#define DUP_MIX -1
#ifndef USE_TR
#define USE_TR 1
#endif

#define LAS __attribute__((address_space(3)))
typedef unsigned short bf16_t;
typedef short bf16x8 __attribute__((ext_vector_type(8)));
typedef short s16x4 __attribute__((ext_vector_type(4)));
typedef float f32x4 __attribute__((ext_vector_type(4)));
typedef unsigned u32x4 __attribute__((ext_vector_type(4)));
typedef unsigned u32x2 __attribute__((ext_vector_type(2)));

constexpr int D = 1024, BATCH = 4, SEQ = 4096, M = BATCH * SEQ, NIN = 5632, NZ = 2560, NG = 3072, FF = 4096, MEMT = 256, MROWS = BATCH * MEMT;
constexpr int OFF_Q = 0, OFF_K = 512, OFF_V = 1024, OFF_F = 1536, OFF_MQ = 2048;
constexpr int ACT_LD = 2048;
constexpr float EPS = 1e-6f;
constexpr size_t MiB = 1u << 20;
constexpr size_t WS_WIN = 0, WS_WKV = 11 * MiB, WS_WCAT = 13 * MiB, WS_WOUT = 17 * MiB, WS_W1 = 19 * MiB, WS_W2 = 27 * MiB, WS_TAB = 35 * MiB,
                 WS_BAR = 35 * MiB + 512 * 1024, WS_NSHIFT = 35 * MiB + 768 * 1024, WS_FUT = 124 * MiB, WS_MEMN = 36 * MiB, WS_MEMKV = 38 * MiB, WS_SSQ = 40 * MiB, WS_G = 44 * MiB, WS_Z = 140 * MiB, WS_H = 220 * MiB,
                 WS_MERGED = 140 * MiB, WS_XMB = 172 * MiB, WS_A = 44 * MiB, WS_END = 256 * MiB;
constexpr int LDS_BYTES = 147456;

typedef float f32x2_t __attribute__((ext_vector_type(2))); typedef __bf16 bf16x2_t __attribute__((ext_vector_type(2)));
__device__ __forceinline__ unsigned cvt_pk_bf16(float lo, float hi) { f32x2_t v = {lo, hi}; bf16x2_t b = __builtin_convertvector(v, bf16x2_t); return __builtin_bit_cast(unsigned, b); }
__device__ __forceinline__ float bf_lo(unsigned w) { return __uint_as_float(w << 16); }
__device__ __forceinline__ float bf_hi(unsigned w) { return __uint_as_float(w & 0xffff0000u); }
__device__ __forceinline__ float bf2f(bf16_t h) { return __uint_as_float(((unsigned)h) << 16); }
__device__ __forceinline__ float wave_sum(float v) {
#pragma unroll
    for (int o = 1; o < 64; o <<= 1) v += __shfl_xor(v, o);
    return v;
}
__device__ __forceinline__ float cosrev(float r) { return __builtin_amdgcn_cosf(r); }
__device__ __forceinline__ float sinrev(float r) { return __builtin_amdgcn_sinf(r); }
typedef __amdgpu_buffer_rsrc_t rsrc_t;
__device__ __forceinline__ rsrc_t mk_rsrc(const void* p) { return __builtin_amdgcn_make_buffer_rsrc((void*)p, 0, 0x7fffffff, 0x00020000); }
__device__ __forceinline__ void st16_wt(rsrc_t r, unsigned byte_off, u32x4 v) { __builtin_amdgcn_raw_buffer_store_b128(v, r, byte_off, 0, 16); }
#define MFMA16(a, b, c) __builtin_amdgcn_mfma_f32_16x16x32_bf16((a), (b), (c), 0, 0, 0)

namespace pg8 {
constexpr int BM = 256, BK = 64, HALF = 128, HTB = HALF * BK * 2, STAGE_BYTES = 8 * HTB, NXCD = 8, WGM = 8;
__host__ __device__ __forceinline__ int lds_byte(int r, int c) { const int st = (r >> 4) * 2 + (c >> 5), rr = r & 15, cc = c & 31, ob = rr * 64 + cc * 2; return st * 1024 + (ob ^ (((ob >> 9) & 1) << 5)); }
__host__ __device__ __forceinline__ void stage_rc(int b, int& R, int& C) { const int st = b / 1024, sb = b % 1024, swz = sb ^ (((sb >> 9) & 1) << 5); R = (st >> 1) * 16 + swz / 64; C = (st & 1) * 32 + (swz % 64) / 2; }
__host__ __device__ __forceinline__ int perm32(int rho) { const int n = rho >> 4, i = rho & 15; return 8 * (i >> 2) + 4 * n + (i & 3); }

struct Unit { int pm, pn, z; };
struct Gemm { const bf16_t* A0; const bf16_t* B0; const bf16_t* A1; const bf16_t* B1; int lda, ldb, K; const bf16_t* P2; size_t kstepA, kstepB; };

struct StaticOrder {
    int nM, nN, nwg, G, c;
    __device__ void init(int M_, int N_, int G_, int c_) { nM = M_ / BM; nN = N_ / BM; nwg = nM * nN; G = G_; c = c_; }
    __device__ __forceinline__ void map(int wgid, Unit& u) const {
        { const int q = nwg / NXCD, r = nwg % NXCD, xcd = wgid % NXCD, off = wgid / NXCD; wgid = (xcd < r ? xcd * (q + 1) : r * (q + 1) + (xcd - r) * q) + off; }
        const int nig = WGM * nN, gid = wgid / nig, fm = gid * WGM, gsz = (nM - fm) < WGM ? (nM - fm) : WGM;
        u.pm = fm + ((wgid % nig) % gsz); u.pn = (wgid % nig) / gsz; u.z = 0;
    }
    __device__ bool next(int i, Unit& u) const { const long L = (long)i * G + c; if (L >= nwg) return false; map((int)L, u); return true; }
};
struct ComboOrder {
    StaticOrder s; int extra, extra_nn, rot;
    __device__ bool next(int i, Unit& u) const {
        const long L = (long)i * s.G + s.c; if (L >= s.nwg + extra) return false;
        if (L < s.nwg) { s.map((int)L, u); u.pn = (u.pn + rot) % s.nN; } else { const int e = (int)L - s.nwg; u.pm = e / extra_nn; u.pn = e % extra_nn; u.z = 1; }
        return true;
    }
};

template <class Epi, class Sched, bool ALIGN_EPI, bool SEGA = false>
__device__ __forceinline__ void gemm_phase(LAS unsigned char* lds, const Gemm g, const Sched& S, const Epi& E) {
    const int tid = threadIdx.x, wid = __builtin_amdgcn_readfirstlane(tid >> 6), lane = tid & 63, wr = wid >> 2, wc = wid & 3, fr = lane & 15, fq = lane >> 4;
    const int K = g.K, nt = K / BK;
    unsigned voffA[2], voffB[2], voffA2[2];
#pragma unroll
    for (int i = 0; i < 2; ++i) { int R, C; stage_rc(tid * 16 + i * 8192, R, C); const int Rb = Epi::PERM ? ((R & ~31) + perm32(R & 31)) : R;
        voffA[i] = (unsigned)(R * g.lda + C) * 2u; voffB[i] = (unsigned)(Rb * g.ldb + C) * 2u; voffA2[i] = (unsigned)((C >> 3) * 4096 + R) * 16u; }
    const size_t kstep = g.kstepA, kstepB = g.kstepB;
    const size_t hstepA = (size_t)HALF * g.lda * 2, hstepB = (size_t)HALF * g.ldb * 2;
    const size_t tstepA = 2 * hstepA, tstepB = 2 * hstepB;
    const unsigned ldsw = (unsigned)wid * 1024u;
    const int aoff = lds_byte(wr * 64 + fr, fq * 8), boff = lds_byte(wc * 32 + fr, fq * 8);
#define PG8_SA(b, h) (((b) * 2 + (h)) * HTB)
#define PG8_SB(b, h) ((4 + (b) * 2 + (h)) * HTB)
#define PG8_STAGE(bufoff, gbase, voff) do { _Pragma("unroll") for (int _i = 0; _i < 2; ++_i) \
        __builtin_amdgcn_global_load_lds((const unsigned*)((const char*)(gbase) + (voff)[_i]), (LAS unsigned*)(lds + (bufoff) + ldsw + _i * 8192), 16, 0, 0); } while (0)
#define PG8_ASTAGE(bufoff, uA, uP, tile, half) do { const int tl_ = (tile); const char* gp_; unsigned o0_, o1_; \
        if (SEGA && (unsigned)(tl_ - 8) < 16u) { gp_ = (uP) + (size_t)(tl_ - 8) * 524288 + (half) * 2048; o0_ = voffA2[0]; o1_ = voffA2[1]; } \
        else { gp_ = (uA) + (size_t)tl_ * kstep + (size_t)(half) * hstepA; o0_ = voffA[0]; o1_ = voffA[1]; } \
        __builtin_amdgcn_global_load_lds((const unsigned*)(gp_ + o0_), (LAS unsigned*)(lds + (bufoff) + ldsw), 16, 0, 0); \
        __builtin_amdgcn_global_load_lds((const unsigned*)(gp_ + o1_), (LAS unsigned*)(lds + (bufoff) + ldsw + 8192), 16, 0, 0); } while (0)
#define PG8_UP2(pm_) ((const char*)g.P2 + ((size_t)((pm_) >> 4) * 128 * 4096 + (size_t)((pm_) & 15) * 256) * 16)
#define PG8_LDA(dst, b, h) do { _Pragma("unroll") for (int m = 0; m < 4; ++m) _Pragma("unroll") for (int k = 0; k < 2; ++k) dst[m][k] = *(const LAS bf16x8*)(lds + PG8_SA(b, h) + aoff + m * 2048 + k * 1024); } while (0)
#define PG8_LDB(dst, b, h) do { _Pragma("unroll") for (int n = 0; n < 2; ++n) _Pragma("unroll") for (int k = 0; k < 2; ++k) dst[n][k] = *(const LAS bf16x8*)(lds + PG8_SB(b, h) + boff + n * 2048 + k * 1024); } while (0)
#define PG8_MMA(ai, bj, At, Bt) do { __builtin_amdgcn_s_setprio(1); _Pragma("unroll") for (int m = 0; m < 4; ++m) _Pragma("unroll") for (int n = 0; n < 2; ++n) _Pragma("unroll") for (int k = 0; k < 2; ++k) \
        acc[ai][bj][m][n] = __builtin_amdgcn_mfma_f32_16x16x32_bf16(Bt[n][k], At[m][k], acc[ai][bj][m][n], 0, 0, 0); __builtin_amdgcn_s_setprio(0); } while (0)
#define PG8_WAIT_V(n) asm volatile("s_waitcnt vmcnt(" #n ")" ::: "memory")
#define PG8_WAIT_L(n) asm volatile("s_waitcnt lgkmcnt(" #n ")" ::: "memory")
#define PG8_BAR __builtin_amdgcn_s_barrier()
#define PG8_SCHED __builtin_amdgcn_sched_barrier(0)
    Unit cur, nxt; int ui = 0;
    if (!S.next(0, cur)) return;
    f32x4 acc[2][2][4][2];
#pragma unroll
    for (int a = 0; a < 2; ++a)
#pragma unroll
        for (int b = 0; b < 2; ++b)
#pragma unroll
            for (int m = 0; m < 4; ++m)
#pragma unroll
                for (int n = 0; n < 2; ++n) acc[a][b][m][n] = (f32x4){0.f, 0.f, 0.f, 0.f};
    bf16x8 At[4][2], B0[2][2], B1[2][2];
    const char* cA = (const char*)(cur.z ? g.A1 : g.A0) + (size_t)cur.pm * tstepA; const char* cB = (const char*)(cur.z ? g.B1 : g.B0) + (size_t)cur.pn * tstepB;
    const char* cP = SEGA ? PG8_UP2(cur.pm) : nullptr;
    PG8_STAGE(PG8_SB(0, 0), cB, voffB); PG8_STAGE(PG8_SB(0, 1), cB + hstepB, voffB); PG8_ASTAGE(PG8_SA(0, 0), cA, cP, 0, 0); PG8_ASTAGE(PG8_SA(0, 1), cA, cP, 0, 1);
    if (wr == 1) PG8_BAR;
    PG8_WAIT_V(2); PG8_BAR;
    PG8_STAGE(PG8_SB(1, 0), cB + kstepB, voffB); PG8_ASTAGE(PG8_SA(1, 0), cA, cP, 1, 0); PG8_STAGE(PG8_SB(1, 1), cB + hstepB + kstepB, voffB);
    PG8_WAIT_V(6); PG8_BAR;
    for (;;) {
        const bool has_next = S.next(ui + 1, nxt);
        const char* nA = has_next ? (const char*)(nxt.z ? g.A1 : g.A0) + (size_t)nxt.pm * tstepA : cA; const char* nB = has_next ? (const char*)(nxt.z ? g.B1 : g.B0) + (size_t)nxt.pn * tstepB : cB;
        const char* nP = (SEGA && has_next) ? PG8_UP2(nxt.pm) : cP;
        for (int t = 0; t < nt; t += 2) {
            if constexpr (Epi::HAS_MID) E.mid(acc, cur, t, wr, wc, fr, fq);
            const bool last = (t == nt - 2);
            const char* uA2 = last ? nA : cA; const char* uP2 = last ? nP : cP; const int t2 = last ? 0 : t + 2;
            const char* b2 = last ? nB : cB + (size_t)(t + 2) * kstepB; const char* b3 = b2 + kstepB;
            PG8_LDB(B0, 0, 0); PG8_LDB(B1, 0, 1); PG8_SCHED; PG8_LDA(At, 0, 0); PG8_ASTAGE(PG8_SA(1, 1), cA, cP, t + 1, 1);
            PG8_WAIT_V(8); PG8_WAIT_L(0); PG8_BAR; PG8_MMA(0, 0, At, B0); PG8_MMA(0, 1, At, B1); PG8_BAR; PG8_SCHED;
            PG8_LDA(At, 0, 1); PG8_STAGE(PG8_SB(0, 0), b2, voffB); PG8_STAGE(PG8_SB(0, 1), b2 + hstepB, voffB); PG8_ASTAGE(PG8_SA(0, 0), uA2, uP2, t2, 0);
            PG8_WAIT_V(8); PG8_WAIT_L(0); PG8_BAR; PG8_MMA(1, 0, At, B0); PG8_MMA(1, 1, At, B1); PG8_BAR; PG8_SCHED;
            PG8_LDB(B0, 1, 0); PG8_LDB(B1, 1, 1); PG8_SCHED; PG8_LDA(At, 1, 0); PG8_ASTAGE(PG8_SA(0, 1), uA2, uP2, t2, 1);
            PG8_WAIT_V(8); PG8_WAIT_L(0); PG8_BAR; PG8_MMA(0, 0, At, B0); PG8_MMA(0, 1, At, B1); PG8_BAR; PG8_SCHED;
            PG8_LDA(At, 1, 1); PG8_STAGE(PG8_SB(1, 0), b3, voffB); PG8_STAGE(PG8_SB(1, 1), b3 + hstepB, voffB); PG8_ASTAGE(PG8_SA(1, 0), uA2, uP2, t2 + 1, 0);
            PG8_WAIT_V(8); PG8_WAIT_L(0); PG8_BAR; PG8_MMA(1, 0, At, B0); PG8_MMA(1, 1, At, B1); PG8_BAR; PG8_SCHED;
        }
        if constexpr (ALIGN_EPI) { if (wr == 0) PG8_BAR; }
        E(acc, cur, wr, wc, fr, fq);
        if (!has_next) break;
#pragma unroll
        for (int a = 0; a < 2; ++a)
#pragma unroll
            for (int b = 0; b < 2; ++b)
#pragma unroll
                for (int m = 0; m < 4; ++m)
#pragma unroll
                    for (int n = 0; n < 2; ++n) acc[a][b][m][n] = (f32x4){0.f, 0.f, 0.f, 0.f};
        cur = nxt; cA = nA; cB = nB; cP = nP; ++ui;
        if constexpr (ALIGN_EPI) { if (wr == 1) PG8_BAR; }
    }
    PG8_WAIT_V(0);
    if constexpr (!ALIGN_EPI) { if (wr == 0) PG8_BAR; }
    PG8_BAR;
#undef PG8_SA
#undef PG8_SB
#undef PG8_STAGE
#undef PG8_LDA
#undef PG8_ASTAGE
#undef PG8_UP2
#undef PG8_LDB
#undef PG8_MMA
#undef PG8_WAIT_V
#undef PG8_WAIT_L
#undef PG8_BAR
#undef PG8_SCHED
}

typedef f32x4 Acc[2][2][4][2];

struct EpiInProj {
    static constexpr bool PERM = true, HAS_MID = false;
    bf16_t* Z; unsigned char* G; bf16_t* MKV; const float* bgate; const float* gq; const float* gk; LAS float* P; bf16_t* FUT;
    __device__ __forceinline__ void operator()(const Acc& acc, const Unit& u, int wr, int wc, int fr, int fq) const {
        const int row0 = u.pm * BM + wr * 64 + fr;
        if (u.z == 0 && u.pn >= NZ / BM) {
            const int col0 = (u.pn - NZ / BM) * BM + wc * 32 + 8 * fq;
            const float NL2E = -1.4426950408889634f, I255 = 1.0f / 255.0f;
            const int gtile = u.pn - NZ / BM;
            unsigned char* gt = G + ((size_t)(((gtile >> 2) * (M / BM) + u.pm) * 4 + (gtile & 3)) * 8 + (wr * 4 + wc)) * 8192 + (fq * 16 + fr) * 16;
            f32x4 bv[2][2];
#pragma unroll
            for (int bj = 0; bj < 2; ++bj)
#pragma unroll
                for (int n = 0; n < 2; ++n) bv[bj][n] = *(const f32x4*)(bgate + col0 + bj * HALF + 4 * n) * NL2E;
#pragma unroll
            for (int ai = 0; ai < 2; ++ai)
#pragma unroll
                for (int m = 0; m < 4; ++m) { u32x4 w16;
#pragma unroll
                    for (int bj = 0; bj < 2; ++bj) { u32x2 w; w.x = 0u; w.y = 0u;
#pragma unroll
                        for (int e = 0; e < 4; ++e) {
                            const float q0 = __builtin_rintf(fmaxf(__builtin_amdgcn_rcpf(fmaf(__builtin_amdgcn_exp2f(fmaf(acc[ai][bj][m][0][e], NL2E, bv[bj][0][e])), I255, I255)), 1.0f));
                            const float q1 = __builtin_rintf(fmaxf(__builtin_amdgcn_rcpf(fmaf(__builtin_amdgcn_exp2f(fmaf(acc[ai][bj][m][1][e], NL2E, bv[bj][1][e])), I255, I255)), 1.0f));
                            w.x = __builtin_amdgcn_cvt_pk_u8_f32(q0, e, w.x); w.y = __builtin_amdgcn_cvt_pk_u8_f32(q1, e, w.y); }
                        if (bj == 0) { w16.x = w.x; w16.y = w.y; } else { w16.z = w.x; w16.w = w.y; } }
                    *(u32x4*)(gt + (ai * 4 + m) * 1024) = w16; }
            return;
        }
        if (u.z == 0 && (u.pn == 6 || u.pn == 7)) {
            const int ch0 = (u.pn - 6) * BM + wc * 32 + 8 * fq;
#pragma unroll
            for (int ai = 0; ai < 2; ++ai)
#pragma unroll
                for (int m = 0; m < 4; ++m) { const int row = row0 + ai * HALF + m * 16, bb = row >> 12, tok = row & 4095;
#pragma unroll
                    for (int bj = 0; bj < 2; ++bj) { const f32x4 v0 = acc[ai][bj][m][0], v1 = acc[ai][bj][m][1]; const int cb0 = (ch0 + bj * HALF) >> 2;
                        u32x2 w0, w1; w0.x = cvt_pk_bf16(v0[0], v0[1]); w0.y = cvt_pk_bf16(v0[2], v0[3]); w1.x = cvt_pk_bf16(v1[0], v1[1]); w1.y = cvt_pk_bf16(v1[2], v1[3]);
                        *(u32x2*)(FUT + (((size_t)(bb * 128 + cb0) * 4096 + tok) * 4)) = w0; *(u32x2*)(FUT + (((size_t)(bb * 128 + cb0 + 1) * 4096 + tok) * 4)) = w1; } }
            return;
        }
        bf16_t* base; int ldc;
        if (u.z == 1) { base = MKV; ldc = D; } else { base = Z; ldc = NZ; }
        const int col0 = u.pn * BM + wc * 32 + 8 * fq;
        const bool qk = (u.z == 0) && (u.pn < 4);
        float rsn[2][4][2]; f32x4 g0 = (f32x4){1.f, 1.f, 1.f, 1.f}, g1 = g0;
        if (qk) {
#pragma unroll
            for (int ai = 0; ai < 2; ++ai)
#pragma unroll
                for (int m = 0; m < 4; ++m)
#pragma unroll
                    for (int bj = 0; bj < 2; ++bj) { const f32x4 a0 = acc[ai][bj][m][0], a1 = acc[ai][bj][m][1];
                        float ss = ((a0[0] * a0[0] + a0[1] * a0[1]) + (a0[2] * a0[2] + a0[3] * a0[3])) + ((a1[0] * a1[0] + a1[1] * a1[1]) + (a1[2] * a1[2] + a1[3] * a1[3]));
                        ss += __shfl_xor(ss, 16); ss += __shfl_xor(ss, 32);
                        if (fq == 0) P[(((ai * HALF + wr * 64 + m * 16 + fr) * 4 + 2 * bj + (wc >> 1)) * 2) + (wc & 1)] = ss; }
            asm volatile("s_waitcnt lgkmcnt(0)" ::: "memory"); __builtin_amdgcn_s_barrier(); asm volatile("" ::: "memory");
#pragma unroll
            for (int ai = 0; ai < 2; ++ai)
#pragma unroll
                for (int m = 0; m < 4; ++m)
#pragma unroll
                    for (int bj = 0; bj < 2; ++bj) { const LAS float* pp = P + (((ai * HALF + wr * 64 + m * 16 + fr) * 4 + 2 * bj + (wc >> 1)) * 2);
                        rsn[ai][m][bj] = rsqrtf((pp[0] + pp[1]) * (1.0f / 64.0f) + EPS); }
            if (u.pn < 2) { const int d0 = 32 * (wc & 1) + 8 * fq; const float sc = 0.125f * 1.4426950408889634f;
#pragma unroll
                for (int e = 0; e < 4; ++e) { g0[e] = gq[d0 + e] * gk[d0 + e] * sc; g1[e] = gq[d0 + 4 + e] * gk[d0 + 4 + e] * sc; } }
        } else {
#pragma unroll
            for (int ai = 0; ai < 2; ++ai)
#pragma unroll
                for (int m = 0; m < 4; ++m) { rsn[ai][m][0] = 1.f; rsn[ai][m][1] = 1.f; }
        }
#pragma unroll
        for (int ai = 0; ai < 2; ++ai)
#pragma unroll
            for (int m = 0; m < 4; ++m) { const unsigned ro = (unsigned)((row0 + ai * HALF + m * 16) * ldc + col0) * 2u;
#pragma unroll
                for (int bj = 0; bj < 2; ++bj) { const f32x4 v0 = acc[ai][bj][m][0] * rsn[ai][m][bj] * g0, v1 = acc[ai][bj][m][1] * rsn[ai][m][bj] * g1;
                    u32x4 w; w.x = cvt_pk_bf16(v0[0], v0[1]); w.y = cvt_pk_bf16(v0[2], v0[3]); w.z = cvt_pk_bf16(v1[0], v1[1]); w.w = cvt_pk_bf16(v1[2], v1[3]);
                    *(u32x4*)((char*)base + ro + bj * HALF * 2) = w; } }
    }
};

__device__ __forceinline__ float ub0(unsigned w) { return (float)(w & 0xffu); }
__device__ __forceinline__ float ub1(unsigned w) { return (float)((w >> 8) & 0xffu); }
__device__ __forceinline__ float ub2(unsigned w) { return (float)((w >> 16) & 0xffu); }
__device__ __forceinline__ float ub3(unsigned w) { return (float)(w >> 24); }
struct EpiMerge {
    static constexpr bool PERM = true, HAS_MID = true;
    const unsigned char* G; bf16_t* O;
    __device__ __forceinline__ const unsigned char* gimg(const Unit& u, int g, int wr, int wc, int fr, int fq) const {
        return G + ((size_t)((g * (M / BM) + u.pm) * 4 + u.pn) * 8 + (wr * 4 + wc)) * 8192 + (fq * 16 + fr) * 16; }
    __device__ __forceinline__ void rescale(Acc& acc, const Unit& u, int ga, int gb, int wr, int wc, int fr, int fq) const {
        const unsigned char* gpa = gimg(u, ga, wr, wc, fr, fq); const unsigned char* gpb = gimg(u, gb, wr, wc, fr, fq);
#pragma unroll
        for (int ai = 0; ai < 2; ++ai) {
            u32x4 a[4], b[4];
#pragma unroll
            for (int m = 0; m < 4; ++m) { a[m] = *(const u32x4*)(gpa + (ai * 4 + m) * 1024); b[m] = *(const u32x4*)(gpb + (ai * 4 + m) * 1024); }
#pragma unroll
            for (int m = 0; m < 4; ++m)
#pragma unroll
                for (int bj = 0; bj < 2; ++bj) { const unsigned ax = bj ? a[m].z : a[m].x, ay = bj ? a[m].w : a[m].y, bx = bj ? b[m].z : b[m].x, by = bj ? b[m].w : b[m].y;
                    f32x4 r0, r1;
                    r0[0] = ub0(ax) * __builtin_amdgcn_rcpf(ub0(bx)); r0[1] = ub1(ax) * __builtin_amdgcn_rcpf(ub1(bx)); r0[2] = ub2(ax) * __builtin_amdgcn_rcpf(ub2(bx)); r0[3] = ub3(ax) * __builtin_amdgcn_rcpf(ub3(bx));
                    r1[0] = ub0(ay) * __builtin_amdgcn_rcpf(ub0(by)); r1[1] = ub1(ay) * __builtin_amdgcn_rcpf(ub1(by)); r1[2] = ub2(ay) * __builtin_amdgcn_rcpf(ub2(by)); r1[3] = ub3(ay) * __builtin_amdgcn_rcpf(ub3(by));
                    acc[ai][bj][m][0] *= r0; acc[ai][bj][m][1] *= r1; }
            asm volatile("" ::: "memory");
        }
    }
    __device__ __forceinline__ void mid(Acc& acc, const Unit& u, int t, int wr, int wc, int fr, int fq) const {
        if (t == 8 || t == 24) { const int ga = (t == 8) ? 0 : 1; rescale(acc, u, ga, ga + 1, wr, wc, fr, fq); }
    }
    __device__ __forceinline__ void operator()(Acc& acc, const Unit& u, int wr, int wc, int fr, int fq) const {
        const int row0 = u.pm * BM + wr * 64 + fr, col0 = u.pn * BM + wc * 32 + 8 * fq;
        const float k = 1.0f / 255.0f; const rsrc_t ro_rs = mk_rsrc(O);
        const unsigned char* gp2 = gimg(u, 2, wr, wc, fr, fq);
        u32x4 a[8];
#pragma unroll
        for (int k8 = 0; k8 < 8; ++k8) a[k8] = *(const u32x4*)(gp2 + k8 * 1024);
#pragma unroll
        for (int ai = 0; ai < 2; ++ai) {
#pragma unroll
            for (int m = 0; m < 4; ++m) { const unsigned ro = (unsigned)((row0 + ai * HALF + m * 16) * D + col0) * 2u; const u32x4 av = a[ai * 4 + m];
#pragma unroll
                for (int bj = 0; bj < 2; ++bj) { const unsigned ax = bj ? av.z : av.x, ay = bj ? av.w : av.y; const f32x4 v0 = acc[ai][bj][m][0] * k, v1 = acc[ai][bj][m][1] * k;
                    u32x4 w; w.x = cvt_pk_bf16(v0[0] * ub0(ax), v0[1] * ub1(ax)); w.y = cvt_pk_bf16(v0[2] * ub2(ax), v0[3] * ub3(ax));
                    w.z = cvt_pk_bf16(v1[0] * ub0(ay), v1[1] * ub1(ay)); w.w = cvt_pk_bf16(v1[2] * ub2(ay), v1[3] * ub3(ay));
                    st16_wt(ro_rs, ro + bj * HALF * 2, w); } }
            asm volatile("" ::: "memory");
        }
    }
};

struct EpiWout {
    static constexpr bool PERM = true, HAS_MID = false;
    const float* X; bf16_t* XMB; float* SSQ; LAS float* P;
    __device__ __forceinline__ void operator()(const Acc& acc, const Unit& u, int wr, int wc, int fr, int fq) const {
        const int col0 = u.pn * BM + wc * 32 + 8 * fq; const rsrc_t xrs = mk_rsrc(XMB);
#pragma unroll
        for (int ai = 0; ai < 2; ++ai) {
            f32x4 xv[4][2][2];
#pragma unroll
            for (int m = 0; m < 4; ++m)
#pragma unroll
                for (int bj = 0; bj < 2; ++bj)
#pragma unroll
                    for (int n = 0; n < 2; ++n) xv[m][bj][n] = *(const f32x4*)(X + (size_t)(u.pm * BM + ai * HALF + wr * 64 + m * 16 + fr) * D + col0 + bj * HALF + n * 4);
#pragma unroll
            for (int m = 0; m < 4; ++m) { const int rl = ai * HALF + wr * 64 + m * 16 + fr; const unsigned ro = (unsigned)((u.pm * BM + rl) * D + col0) * 2u; float s = 0.f;
#pragma unroll
                for (int bj = 0; bj < 2; ++bj) { const f32x4 o0 = xv[m][bj][0] + acc[ai][bj][m][0], o1 = xv[m][bj][1] + acc[ai][bj][m][1];
                    u32x4 w; w.x = cvt_pk_bf16(o0[0], o0[1]); w.y = cvt_pk_bf16(o0[2], o0[3]); w.z = cvt_pk_bf16(o1[0], o1[1]); w.w = cvt_pk_bf16(o1[2], o1[3]);
                    st16_wt(xrs, ro + bj * HALF * 2, w);
                    s += ((o0[0] * o0[0] + o0[1] * o0[1]) + (o0[2] * o0[2] + o0[3] * o0[3])) + ((o1[0] * o1[0] + o1[1] * o1[1]) + (o1[2] * o1[2] + o1[3] * o1[3])); }
                s += __shfl_xor(s, 16); s += __shfl_xor(s, 32);
                if (fq == 0) P[rl * 4 + wc] = s; }
            asm volatile("" ::: "memory");
        }
        asm volatile("s_waitcnt lgkmcnt(0)" ::: "memory"); __builtin_amdgcn_s_barrier(); asm volatile("" ::: "memory");
        const int t = threadIdx.x;
        if (t < 256) { const f32x4 pv = *(const LAS f32x4*)(P + t * 4); SSQ[(size_t)(u.pm * BM + t) * 4 + u.pn] = (pv[0] + pv[1]) + (pv[2] + pv[3]); }
        asm volatile("s_waitcnt lgkmcnt(0)" ::: "memory"); __builtin_amdgcn_s_barrier(); asm volatile("" ::: "memory");
    }
};

struct EpiFfn1 {
    static constexpr bool PERM = true, HAS_MID = false;
    const float* SSQ; bf16_t* O; LAS float* RS;
    __device__ __forceinline__ void operator()(const Acc& acc, const Unit& u, int wr, int wc, int fr, int fq) const {
        volatile LAS int* cpm = (volatile LAS int*)(RS + 256);
        if (*cpm != u.pm) {
            __builtin_amdgcn_s_barrier();
            const int t = threadIdx.x;
            if (t < 256) { const f32x4 s4 = *(const f32x4*)(SSQ + (size_t)(u.pm * BM + t) * 4); RS[t] = rsqrtf(((s4[0] + s4[1]) + (s4[2] + s4[3])) * (1.0f / D) + EPS); }
            if (t == 0) *cpm = u.pm;
            asm volatile("s_waitcnt vmcnt(0) lgkmcnt(0)" ::: "memory"); __builtin_amdgcn_s_barrier(); asm volatile("" ::: "memory");
        }
        const int rl0 = wr * 64 + fr, col0 = u.pn * BM + wc * 32 + 8 * fq; const rsrc_t ors = mk_rsrc(O);
#pragma unroll
        for (int ai = 0; ai < 2; ++ai)
#pragma unroll
            for (int m = 0; m < 4; ++m) { const int rl = rl0 + ai * HALF + m * 16, row = u.pm * BM + rl; const float rs = RS[rl];
                const unsigned ro = (unsigned)((((size_t)(col0 >> 6) * M + row) * 64 + (col0 & 63)) * 2);
#pragma unroll
                for (int bj = 0; bj < 2; ++bj) { f32x4 v0 = acc[ai][bj][m][0] * rs, v1 = acc[ai][bj][m][1] * rs;
#pragma unroll
                    for (int e = 0; e < 4; ++e) { const float a = fmaxf(v0[e], 0.f), b = fmaxf(v1[e], 0.f); v0[e] = a * a; v1[e] = b * b; }
                    u32x4 w; w.x = cvt_pk_bf16(v0[0], v0[1]); w.y = cvt_pk_bf16(v0[2], v0[3]); w.z = cvt_pk_bf16(v1[0], v1[1]); w.w = cvt_pk_bf16(v1[2], v1[3]);
                    st16_wt(ors, ro + (unsigned)bj * (2u * M * 64u * 2u), w); } }
    }
};

struct EpiFfn2 {
    static constexpr bool PERM = false, HAS_MID = false;
    const bf16_t* XMB; float* O;
    __device__ __forceinline__ void operator()(const Acc& acc, const Unit& u, int wr, int wc, int fr, int fq) const {
        const int col0 = u.pn * BM + wc * 32 + 4 * fq;
        u32x2 xb[2][4][2][2];
#pragma unroll
        for (int ai = 0; ai < 2; ++ai)
#pragma unroll
            for (int m = 0; m < 4; ++m) { const size_t off = (size_t)(u.pm * BM + ai * HALF + wr * 64 + m * 16 + fr) * D + col0;
#pragma unroll
                for (int bj = 0; bj < 2; ++bj)
#pragma unroll
                    for (int n = 0; n < 2; ++n) xb[ai][m][bj][n] = *(const u32x2*)(XMB + off + bj * HALF + n * 16); }
#pragma unroll
        for (int ai = 0; ai < 2; ++ai)
#pragma unroll
            for (int m = 0; m < 4; ++m) { const size_t off = (size_t)(u.pm * BM + ai * HALF + wr * 64 + m * 16 + fr) * D + col0;
#pragma unroll
                for (int bj = 0; bj < 2; ++bj)
#pragma unroll
                    for (int n = 0; n < 2; ++n) { const u32x2 w = xb[ai][m][bj][n];
                        f32x4 xv; xv[0] = bf_lo(w.x); xv[1] = bf_hi(w.x); xv[2] = bf_lo(w.y); xv[3] = bf_hi(w.y);
                        *(f32x4*)(O + off + bj * HALF + n * 16) = xv + acc[ai][bj][m][n]; } }
    }
};
}

struct Params {
    const float *x, *mem, *norm1_g, *w_in, *b_gate, *na_q_g, *na_k_g, *na_rpb, *w_na_o, *w_f, *mem_norm_g, *w_mem_kv, *mem_q_g, *mem_k_g, *w_mem_o, *w_out, *norm2_g, *w_ff1, *w_ff2;
    float* out; unsigned char* ws; int ph_lo, ph_hi;
};

__device__ __forceinline__ unsigned f2bf(float f) { unsigned u = __builtin_bit_cast(unsigned, f); return (u + 0x7fffu + ((u >> 16) & 1u)) >> 16; }
__device__ __forceinline__ unsigned pk2(float lo, float hi) { return f2bf(lo) | (f2bf(hi) << 16); }

__device__ __forceinline__ void p0_transpose_item(const float* W, int N, bf16_t* WT, int ldo, int col_off, const float* kscale, LAS float* scr, int item, int lane, size_t ktstride = 0) {
    const int nblk = N / 32, kb = item / nblk, nb = item % nblk, k0 = 64 * kb, n0 = 32 * nb;
    f32x4 v[8];
#pragma unroll
    for (int i = 0; i < 8; ++i) { const int kk = i * 8 + (lane >> 3); v[i] = *(const f32x4*)(W + (size_t)(k0 + kk) * N + n0 + (lane & 7) * 4); }
#pragma unroll
    for (int i = 0; i < 8; ++i) { const int kk = i * 8 + (lane >> 3); const float sc = kscale ? kscale[k0 + kk] : 1.0f; LAS float* d = scr + kk * 33 + (lane & 7) * 4;
        d[0] = v[i][0] * sc; d[1] = v[i][1] * sc; d[2] = v[i][2] * sc; d[3] = v[i][3] * sc; }
    asm volatile("s_waitcnt lgkmcnt(0)" ::: "memory");
    const int c = lane & 7;
#pragma unroll
    for (int j = 0; j < 4; ++j) { const int n = (lane >> 3) + 8 * j; const LAS float* s = scr + (8 * c) * 33 + n;
        u32x4 o; o.x = pk2(s[0 * 33], s[1 * 33]); o.y = pk2(s[2 * 33], s[3 * 33]); o.z = pk2(s[4 * 33], s[5 * 33]); o.w = pk2(s[6 * 33], s[7 * 33]);
        bf16_t* dp = ktstride ? (WT + (size_t)kb * ktstride + (size_t)(n0 + n) * 64 + 8 * c) : (WT + (size_t)(n0 + n) * ldo + col_off + k0 + 8 * c);
        *(u32x4*)dp = o; }
    asm volatile("s_waitcnt lgkmcnt(0)" ::: "memory");
}
__device__ __forceinline__ void rms_rows4_to_bf16(const float* xrow, const float* gvec, bf16_t* orow, int lane) {
    const f32x4* gr = (const f32x4*)gvec + lane;
    f32x4 v[4][4]; float s[4];
#pragma unroll
    for (int r = 0; r < 4; ++r)
#pragma unroll
        for (int j = 0; j < 4; ++j) v[r][j] = ((const f32x4*)(xrow + (size_t)r * D) + lane)[64 * j];
#pragma unroll
    for (int r = 0; r < 4; ++r) { s[r] = 0.f;
#pragma unroll
        for (int j = 0; j < 4; ++j) s[r] += (v[r][j][0] * v[r][j][0] + v[r][j][1] * v[r][j][1]) + (v[r][j][2] * v[r][j][2] + v[r][j][3] * v[r][j][3]); }
#pragma unroll
    for (int o = 1; o < 64; o <<= 1) {
#pragma unroll
        for (int r = 0; r < 4; ++r) s[r] += __shfl_xor(s[r], o); }
    f32x4 gg[4];
#pragma unroll
    for (int j = 0; j < 4; ++j) gg[j] = gr[64 * j];
#pragma unroll
    for (int r = 0; r < 4; ++r) { const float rs = rsqrtf(s[r] * (1.0f / D) + EPS); u32x2* o8 = (u32x2*)(orow + (size_t)r * D) + lane;
#pragma unroll
        for (int j = 0; j < 4; ++j) { u32x2 w; w.x = pk2(v[r][j][0] * rs * gg[j][0], v[r][j][1] * rs * gg[j][1]); w.y = pk2(v[r][j][2] * rs * gg[j][2], v[r][j][3] * rs * gg[j][3]); o8[64 * j] = w; } }
}

#define XB_TMO      128
#define XB_XCNT(j)  (256  + 64 * (j))
#define XB_XSUB(j)  (1280 + 64 * (j))
#define XB_XGEN(j)  (2304 + 64 * (j))
#define XB_TOP      3328
#define XB_TOPGEN   3392
#define XCD_BAR_WORDS 3456
#define XB_SPIN_CAP (1u << 20)
__device__ __forceinline__ unsigned xb_ld(unsigned* p)              { return __hip_atomic_load(p, __ATOMIC_RELAXED, __HIP_MEMORY_SCOPE_AGENT); }
__device__ __forceinline__ unsigned xb_add(unsigned* p, unsigned v) { return __hip_atomic_fetch_add(p, v, __ATOMIC_RELAXED, __HIP_MEMORY_SCOPE_AGENT); }
__device__ __forceinline__ unsigned xb_xcc_id() { return (unsigned)__builtin_amdgcn_s_getreg((3 << 11) | 20) & 0xFu; }
#define XB_SPIN(cond, bar) do { unsigned _sp = 0; while (cond) { __builtin_amdgcn_s_sleep(1); \
    if ((++_sp & 255u) == 0u) { if (xb_ld(&(bar)[XB_TMO])) break; if (_sp > XB_SPIN_CAP) { atomicAdd(&(bar)[XB_TMO], 1u); break; } } } } while (0)
struct XcdBarrier { unsigned* bar; unsigned x; volatile LAS unsigned* st; };
__device__ __forceinline__ XcdBarrier xcd_barrier_post(unsigned* bar, volatile LAS unsigned* st) {
    XcdBarrier b; b.bar = bar; b.x = xb_xcc_id(); b.st = st;
    if (threadIdx.x == 0) (void)xb_add(&bar[XB_XCNT(b.x)], 1u);
    return b;
}
__device__ __forceinline__ void xcd_barrier_complete(unsigned* bar, unsigned x, unsigned& nloc, unsigned& nx) {
    const unsigned G = gridDim.x * gridDim.y * gridDim.z;
    unsigned sum, cnt, mine, sp = 0u;
    for (;;) {
        sum = 0u; cnt = 0u; mine = 0u;
#pragma unroll
        for (unsigned j = 0; j < 16; ++j) { const unsigned c = xb_ld(&bar[XB_XCNT(j)]); sum += c; cnt += (c > 0u) ? 1u : 0u; mine = (j == x) ? c : mine; }
        if (sum == G) break;
        __builtin_amdgcn_s_sleep(1);
        if ((++sp & 255u) == 0u) { if (xb_ld(&bar[XB_TMO])) break; if (sp > XB_SPIN_CAP) { atomicAdd(&bar[XB_TMO], 1u); break; } }
    }
    nloc = mine > 0u ? mine : 1u; nx = cnt > 0u ? cnt : 1u;
}
__device__ __forceinline__ void xcd_barrier(const XcdBarrier& b) {
    asm volatile("s_waitcnt vmcnt(0)" ::: "memory");
    __syncthreads();
    if (threadIdx.x == 0) {
        unsigned* bar = b.bar;
        __builtin_amdgcn_s_waitcnt(0);
        unsigned nloc = b.st[0], nx = b.st[1];
        if (nloc == 0u) { xcd_barrier_complete(bar, b.x, nloc, nx); b.st[0] = nloc; b.st[1] = nx; }
        const unsigned old = xb_add(&bar[XB_XSUB(b.x)], 1u);
        const unsigned gen = old / nloc;
        if (old + 1u == (gen + 1u) * nloc) {
            __builtin_amdgcn_fence(__ATOMIC_RELEASE, "agent");
            asm volatile("s_waitcnt vmcnt(0)" ::: "memory");
            const unsigned og = xb_add(&bar[XB_TOP], 1u);
            const unsigned tg = og / nx;
            if (og + 1u == (tg + 1u) * nx) xb_add(&bar[XB_TOPGEN], 1u);
            else XB_SPIN(xb_ld(&bar[XB_TOPGEN]) == tg, bar);
            __builtin_amdgcn_fence(__ATOMIC_ACQUIRE, "agent");
            xb_add(&bar[XB_XGEN(b.x)], 1u);
            asm volatile("s_waitcnt vmcnt(0)" ::: "memory");
        } else {
            XB_SPIN(xb_ld(&bar[XB_XGEN(b.x)]) == gen, bar);
            __builtin_amdgcn_fence(__ATOMIC_ACQUIRE, "agent");
            asm volatile("s_waitcnt vmcnt(0)" ::: "memory");
        }
    }
    __syncthreads();
}

__global__ void __launch_bounds__(512, 2) fwd_kernel(Params p) {
    extern __shared__ __attribute__((aligned(16))) unsigned char lds_raw[];
    LAS unsigned char* lds = (LAS unsigned char*)lds_raw;
    const int tid = threadIdx.x, lane = tid & 63, wave = __builtin_amdgcn_readfirstlane(tid >> 6);
    const int G = gridDim.x, bid = blockIdx.x;
    unsigned char* ws = p.ws;
    bf16_t* WinT = (bf16_t*)(ws + WS_WIN); bf16_t* WkvT = (bf16_t*)(ws + WS_WKV); bf16_t* Wcat = (bf16_t*)(ws + WS_WCAT); bf16_t* WoutT = (bf16_t*)(ws + WS_WOUT);
    bf16_t* W1T = (bf16_t*)(ws + WS_W1); bf16_t* W2T = (bf16_t*)(ws + WS_W2);
    bf16_t* D1f = (bf16_t*)(ws + WS_TAB); bf16_t* D2f = D1f + 8192;
    bf16_t* memn = (bf16_t*)(ws + WS_MEMN); bf16_t* memkv = (bf16_t*)(ws + WS_MEMKV); float* ssq = (float*)(ws + WS_SSQ);
    unsigned char* gbuf = (unsigned char*)(ws + WS_G); bf16_t* zbuf = (bf16_t*)(ws + WS_Z); bf16_t* hbuf = (bf16_t*)(ws + WS_H);
    bf16_t* merged = (bf16_t*)(ws + WS_MERGED); bf16_t* xmb = (bf16_t*)(ws + WS_XMB); bf16_t* abuf = (bf16_t*)(ws + WS_A);
    bf16_t* pimg = hbuf;
    bf16_t* fuT = (bf16_t*)(ws + WS_FUT);
    bf16_t* act = (bf16_t*)p.out;

    const int lo = p.ph_lo, hi = p.ph_hi;
#ifdef ONLY_PHASE
#define IN(k) ((k) == ONLY_PHASE && lo <= (k) && (k) < hi)
#else
#define IN(k) (lo <= (k) && (k) < hi)
#endif
#define BOTH(k) (IN(k) && IN((k) + 1))
#define CG_SYNC() do { asm volatile("s_waitcnt vmcnt(0) lgkmcnt(0)" ::: "memory"); __syncthreads(); cg::this_grid().sync(); \
        if (threadIdx.x == 0) { __builtin_amdgcn_fence(__ATOMIC_ACQUIRE, "agent"); asm volatile("s_waitcnt vmcnt(0)" ::: "memory"); } __syncthreads(); } while (0)
#define GRID_SYNC() do { xcd_barrier(xbar); } while (0)
    volatile LAS unsigned* xst = (volatile LAS unsigned*)(lds + LDS_BYTES - 16);
    if (tid == 0) { xst[0] = 0u; xst[1] = 0u; }
    __syncthreads();
    XcdBarrier xbar = xcd_barrier_post((unsigned*)(ws + WS_BAR), xst);

    if (IN(0)) for (int rep_ = 0; rep_ < NREP(0); ++rep_) {
        if (rep_) GRID_SYNC();
        LAS float* scr = (LAS float*)(lds + wave * 16384);
        LAS float* ctab = (LAS float*)(lds + 131072);
        if (tid < 128) { ctab[tid] = cosrev((float)tid * (1.0f / 128.0f)); ctab[128 + tid] = sinrev((float)tid * (1.0f / 128.0f)); }
        __syncthreads();
        const int gw = bid * 8 + wave, NGW = G * 8;
        constexpr int I_IN = 16 * (NIN / 32), I_KV = 16 * 32;
        for (int it = gw; it < I_IN + I_KV; it += NGW) {
            if (it < I_IN) p0_transpose_item(p.w_in, NIN, WinT, D, 0, nullptr, scr, it, lane);
            else p0_transpose_item(p.w_mem_kv, D, WkvT, D, 0, nullptr, scr, it - I_IN, lane);
        }
        for (int m = gw * 4; m < M + MROWS; m += NGW * 4) {
            if (m < M) rms_rows4_to_bf16(p.x + (size_t)m * D, p.norm1_g, hbuf + (size_t)m * D, lane);
            else rms_rows4_to_bf16(p.mem + (size_t)(m - M) * D, p.mem_norm_g, memn + (size_t)(m - M) * D, lane);
        }
        for (int it = gw; it < 2048; it += NGW) {
            const int g = it >> 9, nb = (it >> 3) & 63, c0 = (it & 7) * 16, li = lane & 15, lk = lane >> 4, c = c0 + li;
            const float* wsrc = p.w_f + (size_t)(g * 128 + lk) * D + nb * 16 + li;
            f32x4 aC = (f32x4){0.f, 0.f, 0.f, 0.f}, aS = (f32x4){0.f, 0.f, 0.f, 0.f};
#pragma unroll 8
            for (int ks = 0; ks < 32; ++ks) { const float a = wsrc[(size_t)(4 * ks) * D]; const int idx = (c * (4 * ks + lk)) & 127;
                aC = __builtin_amdgcn_mfma_f32_16x16x4f32(a, ctab[idx], aC, 0, 0, 0); aS = __builtin_amdgcn_mfma_f32_16x16x4f32(a, ctab[128 + idx], aS, 0, 0, 0); }
            const float sc = 0.08838834764831845f;
            bf16_t* dst = Wcat + (size_t)(nb * 16 + 4 * lk) * 2048 + 512 + (g * 32 + (c >> 2)) * 8 + 2 * (c & 3);
#pragma unroll
            for (int e = 0; e < 4; ++e) *(unsigned*)(dst + (size_t)e * 2048) = pk2(aC[e] * sc, aS[e] * sc);
        }
        for (int e = bid * 512 + tid; e < 8192 + 16384; e += G * 512) {
            if (e < 8192) { const int j = e & 7, ln = (e >> 3) & 63, ks = (e >> 9) & 1, mb = e >> 10; const int r = ln & 15, gq = ln >> 4;
                const int kb = 16 * (mb >> 1) + r, part = mb & 1, sb = ks * 32 + 8 * gq + j; const float rev = (float)((kb * sb) & 63) * (1.0f / 64.0f);
                D1f[e] = (bf16_t)f2bf(part ? -sinrev(rev) : cosrev(rev)); }
            else { const int e2 = e - 8192; const int j = e2 & 7, ln = (e2 >> 3) & 63, ks = (e2 >> 9) & 3, mb = e2 >> 11; const int r = ln & 15, gq = ln >> 4;
                const int o = r & 1, ka = 8 * mb + (r >> 1), k = ks * 32 + 8 * gq + j, sa = k >> 1, i = k & 1; const float rev = (float)((ka * sa) & 63) * (1.0f / 64.0f);
                const float cv = cosrev(rev), sv = sinrev(rev); const float val = (o == 0) ? (i == 0 ? cv : sv) : (i == 0 ? -sv : cv);
                D2f[e2] = (bf16_t)f2bf(val); }
        }
        __syncthreads();
    }
    if (BOTH(0)) GRID_SYNC();
    if (p.ph_lo == 0x7fffffff) CG_SYNC();

    if (IN(1)) for (int rep_ = 0; rep_ < NREP(1); ++rep_) {
        if (rep_) GRID_SYNC();
        pg8::Gemm g{hbuf, WinT, memn, WkvT, D, D, D, nullptr, 128, 128};
        pg8::ComboOrder S; S.s.init(M, NIN, G, bid); S.extra = (MROWS / 256) * (D / 256); S.extra_nn = D / 256; S.rot = 10;
        pg8::EpiInProj E{zbuf, gbuf, memkv, p.b_gate, p.na_q_g, p.na_k_g, (LAS float*)(lds + 131072), fuT};
        pg8::gemm_phase<pg8::EpiInProj, pg8::ComboOrder, true>(lds, g, S, E);
        {
            constexpr int NTILES = (M / 256) * (NIN / 256) + (MROWS / 256) * (D / 256);
            const int nfull = NTILES % G;
            int nw = G - nfull, first = nfull; if (nfull == 0 || nw < 32) { nw = G; first = 0; }
            if (bid >= first) {
                LAS float* scr = (LAS float*)(lds + wave * 16384);
                if (bid == G - 1 && wave == 0) {
                    float mg = fabsf(p.na_q_g[lane] * p.na_k_g[lane]), mb_ = 0.f;
                    for (int e = lane; e < 8 * 465; e += 64) mb_ = fmaxf(mb_, fabsf(p.na_rpb[e]));
#pragma unroll
                    for (int o = 1; o < 64; o <<= 1) { mg = fmaxf(mg, __shfl_xor(mg, o)); mb_ = fmaxf(mb_, __shfl_xor(mb_, o)); }
                    if (lane == 0) *(float*)(ws + WS_NSHIFT) = 8.0f * mg + mb_;
                }
                const int gw = (bid - first) * 8 + wave, NGW = nw * 8;
                constexpr int I_NAO = 8 * 32, I_MO = 8 * 32, I_OUT = 16 * 32, I_1 = 16 * (FF / 32), I_2 = 64 * 32;
                constexpr int NT_ITEMS = I_NAO + I_MO + I_OUT + I_1 + I_2;
                for (int it = gw; it < NT_ITEMS; it += NGW) {
                    int r = it;
                    if (r < I_NAO) { p0_transpose_item(p.w_na_o, D, Wcat, 2048, 0, nullptr, scr, r, lane); continue; } r -= I_NAO;
                    if (r < I_MO) { p0_transpose_item(p.w_mem_o, D, Wcat, 2048, 1536, nullptr, scr, r, lane); continue; } r -= I_MO;
                    if (r < I_OUT) { p0_transpose_item(p.w_out, D, WoutT, D, 0, nullptr, scr, r, lane); continue; } r -= I_OUT;
                    if (r < I_1) { p0_transpose_item(p.w_ff1, FF, W1T, D, 0, p.norm2_g, scr, r, lane); continue; } r -= I_1;
                    p0_transpose_item(p.w_ff2, D, W2T, FF, 0, nullptr, scr, r, lane, (size_t)D * 64);
                }

                __syncthreads();
            }
        }
    }
    if (BOTH(1)) GRID_SYNC();

    if (IN(2)) for (int rep_ = 0; rep_ < NREP(2); ++rep_) {
        if (rep_) GRID_SYNC();
        const int vb = (G % 8 == 0) ? (bid & 7) * (G >> 3) + (bid >> 3) : bid;
        const bool al = (G == 256); const int xq = bid & 7, jq = bid >> 3;
#ifndef NO_NA
        for (int rm_ = 0; rm_ < ((DUP_MIX == 0) ? 2 : 1); ++rm_) {
            int lane_o = lane, tid_o = tid; asm volatile("" : "+v"(lane_o), "+v"(tid_o)); const int q16 = lane_o & 15, g4 = lane_o >> 4;
            const int hs = wave >> 2, rsel = (wave >> 1) & 1, qp = wave & 1;
            LAS float* sbias = (LAS float*)(lds + 65536);
            LAS float* bpad = (LAS float*)(lds + 69632);
            for (int e = tid_o; e < 465; e += 512) bpad[e] = -1e30f;
            int hq_prev = -1;
            int boff[2][2][4];
#pragma unroll
            for (int qbi = 0; qbi < 2; ++qbi) { const int qb = 2 * qp + qbi; const int kstart = (qb == 0) ? 0 : (qb == 1) ? 8 : (qb == 2) ? 24 : 32; const int c = 16 * qb + q16, cs = min(max(c - 8, 0), 48);
#pragma unroll
                for (int kb = 0; kb < 2; ++kb)
#pragma unroll
                    for (int e = 0; e < 4; ++e) { const int kc = kstart + 16 * kb + 4 * g4 + e; const bool valid = (kc >= cs) && (kc < cs + 16);
                        boff[qbi][kb][e] = valid ? (65536 + (hs * 465 + (kc - c + 15)) * 4) : 69632; } }
            for (int un = vb, kq = 0; un < BATCH * 32 * 4; un += G, ++kq) {
                int b = un >> 7, rp = (un >> 2) & 31, hq = un & 3;
                if (al) { const int lu = kq * 32 + jq; b = xq >> 1; rp = 16 * (xq & 1) + (lu >> 2); hq = lu & 3; }
                const int h = hq * 2 + hs, r = 2 * rp + rsel;
                const int rs_r = min(max(r - 4, 0), 56), kr_lo = min(max(2 * rp - 4, 0), 56), nrows = min(max(2 * rp + 1 - 4, 0), 56) + 8 - kr_lo;
                const size_t tok0 = (size_t)b * SEQ;
                __syncthreads();
                if (hq != hq_prev) { const float nshift = *(const float*)(ws + WS_NSHIFT);
                    for (int e = tid_o; e < 2 * 465; e += 512) sbias[e] = (p.na_rpb[hq * 2 * 465 + e] - nshift) * 1.4426950408889634f; hq_prev = hq; }
                u32x4 kreg[2][2], vreg[2][2];
#define NA_LOAD_ROW(kr_, st_) do { const size_t kt_ = tok0 + (size_t)(kr_) * 64; _Pragma("unroll") for (int i = 0; i < 2; ++i) { const int cid = i * 512 + tid_o, key = (cid >> 3) & 63, ch = cid & 7, hsl = cid >> 9; \
                        const bf16_t* sp_ = zbuf + (kt_ + key) * NZ + (hq * 2 + hsl) * 64 + ch * 8; kreg[st_][i] = *(const u32x4*)(sp_ + OFF_K); vreg[st_][i] = *(const u32x4*)(sp_ + OFF_V); } } while (0)
#define NA_WRITE_ROW(buf_, st_) do { _Pragma("unroll") for (int i = 0; i < 2; ++i) { const int cid = i * 512 + tid_o, key = (cid >> 3) & 63, ch = cid & 7, hsl = cid >> 9; \
                        LAS unsigned char* kb_ = lds + (buf_) * 32768 + hsl * 16384 + key * 128 + ((ch ^ (key & 7)) * 16); \
                        *(LAS u32x4*)kb_ = kreg[st_][i]; *(LAS u32x4*)(kb_ + 8192) = vreg[st_][i]; } } while (0)
                NA_LOAD_ROW(kr_lo, 0); NA_LOAD_ROW(kr_lo + 1, 1);
                bf16x8 qf[2][2];
#pragma unroll
                for (int qbi = 0; qbi < 2; ++qbi) {
                    const int qb = 2 * qp + qbi;
                    const bf16_t* src = zbuf + (tok0 + r * 64 + 16 * qb + q16) * NZ + OFF_Q + h * 64;
                    qf[qbi][0] = *(const bf16x8*)(src + 8 * g4); qf[qbi][1] = *(const bf16x8*)(src + 32 + 8 * g4);
                }
                NA_WRITE_ROW(0, 0);
                float lrun[2]; f32x4 O[2][4];
#pragma unroll
                for (int qbi = 0; qbi < 2; ++qbi) { lrun[qbi] = 0.f;
#pragma unroll
                    for (int db = 0; db < 4; ++db) O[qbi][db] = (f32x4){0.f, 0.f, 0.f, 0.f}; }
                asm volatile("s_waitcnt lgkmcnt(0)" ::: "memory"); __builtin_amdgcn_s_barrier(); asm volatile("" ::: "memory");
#define NA_ROW(i_, cur_) do { const int kr = kr_lo + (i_); \
                    if ((i_) + 2 < nrows) NA_LOAD_ROW(kr + 2, cur_); \
                    if (kr >= rs_r && kr < rs_r + 8) {            \
                        const LAS unsigned char* Kb = lds + (cur_) * 32768 + hs * 16384; const LAS unsigned char* Vb = Kb + 8192; \
                        const int dr124 = (kr - r + 7) * 124; \
                        _Pragma("unroll") for (int qbi = 0; qbi < 2; ++qbi) { \
                            const int qb = 2 * qp + qbi; const int kstart = (qb == 0) ? 0 : (qb == 1) ? 8 : (qb == 2) ? 24 : 32; \
                            float pe[2][4]; float ps = 0.f; \
                            _Pragma("unroll") for (int kb = 0; kb < 2; ++kb) { \
                                const int key = kstart + 16 * kb + q16, sw = key & 7; \
                                const bf16x8 k0 = *(const LAS bf16x8*)(Kb + key * 128 + ((g4 ^ sw) * 16)), k1 = *(const LAS bf16x8*)(Kb + key * 128 + (((4 + g4) ^ sw) * 16)); \
                                f32x4 sa = (f32x4){0.f, 0.f, 0.f, 0.f}; \
                                sa = MFMA16(k0, qf[qbi][0], sa); sa = MFMA16(k1, qf[qbi][1], sa); \
                                _Pragma("unroll") for (int e = 0; e < 4; ++e) { const float bv = *(const LAS float*)(lds + boff[qbi][kb][e] + dr124); pe[kb][e] = __builtin_amdgcn_exp2f(sa[e] + bv); ps += pe[kb][e]; } \
                            } \
                            lrun[qbi] += ps; \
                            u32x4 pw; pw.x = cvt_pk_bf16(pe[0][0], pe[0][1]); pw.y = cvt_pk_bf16(pe[0][2], pe[0][3]); pw.z = cvt_pk_bf16(pe[1][0], pe[1][1]); pw.w = cvt_pk_bf16(pe[1][2], pe[1][3]); \
                            const bf16x8 pf = __builtin_bit_cast(bf16x8, pw); \
                            const int qq = q16 >> 2, pp = q16 & 3; \
                            const int rlo = kstart + 4 * g4 + qq, rhi = rlo + 16; \
                            _Pragma("unroll") for (int db = 0; db < 4; ++db) { \
                                const int chv = db * 2 + (pp >> 1), sub = (pp & 1) * 8; \
                                const s16x4 lo4 = __builtin_amdgcn_ds_read_tr16_b64_v4i16((LAS s16x4*)(Vb + rlo * 128 + ((chv ^ (rlo & 7)) * 16) + sub)); \
                                const s16x4 hi4 = __builtin_amdgcn_ds_read_tr16_b64_v4i16((LAS s16x4*)(Vb + rhi * 128 + ((chv ^ (rhi & 7)) * 16) + sub)); \
                                const bf16x8 vf = __builtin_shufflevector(lo4, hi4, 0, 1, 2, 3, 4, 5, 6, 7); \
                                O[qbi][db] = MFMA16(vf, pf, O[qbi][db]); \
                            } \
                        } \
                    } \
                    if ((i_) + 1 < nrows) NA_WRITE_ROW((cur_) ^ 1, (cur_) ^ 1); \
                    asm volatile("s_waitcnt lgkmcnt(0)" ::: "memory"); __builtin_amdgcn_s_barrier(); asm volatile("" ::: "memory"); } while (0)
#pragma unroll 1
                for (int i2 = 0; i2 < 10; i2 += 2) {
                    if (i2 < nrows) NA_ROW(i2, 0);
                    if (i2 + 1 < nrows) NA_ROW(i2 + 1, 1);
                }
#undef NA_ROW
#undef NA_LOAD_ROW
#undef NA_WRITE_ROW
#pragma unroll
                for (int qbi = 0; qbi < 2; ++qbi) { const int qb = 2 * qp + qbi; float lt = lrun[qbi]; lt += __shfl_xor(lt, 16); lt += __shfl_xor(lt, 32); const float il = 1.0f / lt;
                    bf16_t* dst = act + (tok0 + r * 64 + 16 * qb + q16) * ACT_LD + h * 64 + ((g4 & 1) ? 16 + 4 * (g4 - 1) : 4 * g4);
#pragma unroll
                    for (int dp = 0; dp < 2; ++dp) { const f32x4 oa = O[qbi][2 * dp] * il, ob = O[qbi][2 * dp + 1] * il;
                        const auto rx = __builtin_amdgcn_permlane16_swap(cvt_pk_bf16(oa[0], oa[1]), cvt_pk_bf16(ob[0], ob[1]), false, false);
                        const auto ry = __builtin_amdgcn_permlane16_swap(cvt_pk_bf16(oa[2], oa[3]), cvt_pk_bf16(ob[2], ob[3]), false, false);
                        u32x4 w; w.x = rx[0]; w.y = ry[0]; w.z = rx[1]; w.w = ry[1];
                        *(u32x4*)(dst + dp * 32) = w; } }
            }
            __syncthreads();
        }
#endif
#ifndef NO_FFT
        for (int rm_ = 0; rm_ < ((DUP_MIX == 1) ? 2 : 1); ++rm_) {
            int lane_o = lane, tid_o = tid; asm volatile("" : "+v"(lane_o), "+v"(tid_o)); const int q16 = lane_o & 15, g4 = lane_o >> 4;
            constexpr int ZP = 272;
            LAS unsigned char* Zt = lds;
            LAS unsigned char* XI = lds + 69632;
            u32x4 xin[4];
#define FFT_UNIT(kq_, b_, cb_) do { b_ = (vb + (kq_) * G) >> 7; cb_ = (vb + (kq_) * G) & 127; if (al) { b_ = xq >> 1; cb_ = 64 * (xq & 1) + (kq_) * 32 + jq; } } while (0)
#define FFT_FETCH(b_, cb_) do { const bf16_t* sp_ = fuT + (size_t)((b_) * 128 + (cb_)) * 4096 * 4; _Pragma("unroll") for (int i = 0; i < 4; ++i) xin[i] = *(const u32x4*)(sp_ + (size_t)(i * 512 + tid_o) * 8); } while (0)
            { int b0_, cb0_; FFT_UNIT(0, b0_, cb0_); if (vb < BATCH * 128) FFT_FETCH(b0_, cb0_); }
            for (int un = vb, kq = 0; un < BATCH * 128; un += G, ++kq) {
                int b, cb; FFT_UNIT(kq, b, cb);
                asm volatile("s_waitcnt lgkmcnt(0)" ::: "memory"); __builtin_amdgcn_s_barrier(); asm volatile("" ::: "memory");
#pragma unroll
                for (int i = 0; i < 4; ++i) *(LAS u32x4*)(XI + (i * 512 + tid_o) * 16) = xin[i];
                asm volatile("s_waitcnt lgkmcnt(0)" ::: "memory"); __builtin_amdgcn_s_barrier(); asm volatile("" ::: "memory");
#pragma unroll 1
                for (int ngi = 0; ngi < 2; ++ngi) {
                    const int ng = 2 * wave + ngi, sa = 4 * ng + (q16 >> 2), c = q16 & 3;
                    const LAS unsigned char* xp = XI + (sa + 512 * g4) * 8 + c * 2;
                    bf16x8 bfr[2];
#pragma unroll
                    for (int ks = 0; ks < 2; ++ks)
#pragma unroll
                        for (int j = 0; j < 8; ++j) bfr[ks][j] = *(const LAS short*)(xp + (64 * (ks * 32 + j)) * 8);
                    f32x4 acc[8];
#pragma unroll
                    for (int mb = 0; mb < 8; ++mb) { acc[mb] = (f32x4){0.f, 0.f, 0.f, 0.f};
#pragma unroll
                        for (int ks = 0; ks < 2; ++ks) { const bf16x8 af = *(const bf16x8*)(D1f + ((mb * 2 + ks) * 64 + lane_o) * 8); acc[mb] = MFMA16(af, bfr[ks], acc[mb]); } }
#pragma unroll
                    for (int t = 0; t < 4; ++t)
#pragma unroll
                        for (int e = 0; e < 4; ++e) { const int kb = 16 * t + 4 * g4 + e; const float rev = (float)(kb * sa) * (1.0f / 4096.0f);
                            const float ct = cosrev(rev), st = sinrev(rev), zr = acc[2 * t][e], zi = acc[2 * t + 1][e];
                            *(LAS unsigned*)(Zt + (kb * 4 + c) * ZP + sa * 4) = cvt_pk_bf16(zr * ct + zi * st, zi * ct - zr * st); }
                }
                if (un + G < BATCH * 128) { int b2_, cb2_; FFT_UNIT(kq + 1, b2_, cb2_); FFT_FETCH(b2_, cb2_); }
                asm volatile("s_waitcnt lgkmcnt(0)" ::: "memory"); __builtin_amdgcn_s_barrier(); asm volatile("" ::: "memory");
                {
                    const int mb = wave; bf16x8 af[4];
#pragma unroll
                    for (int ks = 0; ks < 4; ++ks) af[ks] = *(const bf16x8*)(D2f + ((mb * 4 + ks) * 64 + lane_o) * 8);
                    LAS unsigned char* OUTI = lds + 69632;
#pragma unroll 4
                    for (int nb = 0; nb < 16; ++nb) {
                        f32x4 a2 = (f32x4){0.f, 0.f, 0.f, 0.f};
#pragma unroll
                        for (int ks = 0; ks < 4; ++ks) { const bf16x8 bfg = *(const LAS bf16x8*)(Zt + (nb * 16 + q16) * ZP + ks * 64 + g4 * 16); a2 = MFMA16(af[ks], bfg, a2); }
                        const int kb = 4 * nb + (q16 >> 2), c = q16 & 3, ka0 = 8 * mb + 2 * g4;
                        *(LAS unsigned*)(OUTI + (64 * ka0 + kb) * 16 + c * 4) = cvt_pk_bf16(a2[0] * (1.0f / 64.0f), a2[1] * (1.0f / 64.0f));
                        *(LAS unsigned*)(OUTI + (64 * (ka0 + 1) + kb) * 16 + c * 4) = cvt_pk_bf16(a2[2] * (1.0f / 64.0f), a2[3] * (1.0f / 64.0f));
                    }
                    asm volatile("s_waitcnt lgkmcnt(0)" ::: "memory"); __builtin_amdgcn_s_barrier(); asm volatile("" ::: "memory");
                    bf16_t* dstp = pimg + ((size_t)(b * 128 + cb) * 4096) * 8;
#pragma unroll
                    for (int i = 0; i < 8; ++i) { const int id = i * 512 + tid_o; *(u32x4*)(dstp + (size_t)id * 8) = *(const LAS u32x4*)(OUTI + id * 16); }
                }
            }
            __syncthreads();
        }
#undef FFT_UNIT
#undef FFT_FETCH
#endif
#ifndef NO_CROSS
        for (int rm_ = 0; rm_ < ((DUP_MIX == 2) ? 2 : 1); ++rm_) {
            int lane_o = lane, tid_o = tid; asm volatile("" : "+v"(lane_o), "+v"(tid_o)); const int q16 = lane_o & 15, g4 = lane_o >> 4;
            constexpr int KP = 272;
            LAS unsigned char* Ks = lds; LAS unsigned char* Vm = lds + 69632; LAS float* rsk = (LAS float*)(lds + 139264);
            for (int un = vb; un < BATCH * 4 * 16; un += G) {
                int b = un >> 6, hm = (un >> 4) & 3, qt = un & 15;
                if (al) { const int pmq = 8 * xq + (jq >> 2); b = pmq >> 4; qt = pmq & 15; hm = jq & 3; }
                __syncthreads();
#pragma unroll
                for (int i = 0; i < 8; ++i) { const int id = i * 512 + tid_o, row = id >> 4, ch = id & 15;

#ifdef EXP_KV_FROM_MEMN
                    const bf16_t* src = memn + ((size_t)b * MEMT + row) * D + hm * 128 + ch * 8;
#else
                    const bf16_t* src = memkv + ((size_t)b * MEMT + row) * D + hm * 128 + ch * 8;
#endif

                    const u32x4 kv = *(const u32x4*)src; const u32x4 vv = *(const u32x4*)(src + 512);
                    float s = 0.f, t;
                    t = bf_lo(kv.x); s += t * t; t = bf_hi(kv.x); s += t * t; t = bf_lo(kv.y); s += t * t; t = bf_hi(kv.y); s += t * t;
                    t = bf_lo(kv.z); s += t * t; t = bf_hi(kv.z); s += t * t; t = bf_lo(kv.w); s += t * t; t = bf_hi(kv.w); s += t * t;
                    s += __shfl_xor(s, 1); s += __shfl_xor(s, 2); s += __shfl_xor(s, 4); s += __shfl_xor(s, 8);
                    if (ch == 0) rsk[row] = rsqrtf(s * (1.0f / 128.0f) + EPS);
                    *(LAS u32x4*)(Ks + row * KP + ch * 16) = kv; *(LAS u32x4*)(Vm + row * KP + ch * 16) = vv; }
                __syncthreads();
#pragma unroll 1
                for (int qbi = 0; qbi < 2; ++qbi) {
                    const size_t tok = (size_t)b * SEQ + qt * 256 + wave * 32 + qbi * 16 + q16;
                    const bf16_t* src = zbuf + tok * NZ + OFF_MQ + hm * 128;
                    bf16x8 qf[4];
                    { u32x4 raw[4]; float s = 0.f;
#pragma unroll
                      for (int ks = 0; ks < 4; ++ks) { raw[ks] = *(const u32x4*)(src + ks * 32 + 8 * g4); float t;
                          t = bf_lo(raw[ks].x); s += t * t; t = bf_hi(raw[ks].x); s += t * t; t = bf_lo(raw[ks].y); s += t * t; t = bf_hi(raw[ks].y); s += t * t;
                          t = bf_lo(raw[ks].z); s += t * t; t = bf_hi(raw[ks].z); s += t * t; t = bf_lo(raw[ks].w); s += t * t; t = bf_hi(raw[ks].w); s += t * t; }
                      s += __shfl_xor(s, 16); s += __shfl_xor(s, 32);
                      const float rq = rsqrtf(s * (1.0f / 128.0f) + EPS) * 0.08838834764831845f;
#pragma unroll
                      for (int ks = 0; ks < 4; ++ks) { const int d0 = ks * 32 + 8 * g4; float gg[8];
#pragma unroll
                          for (int j = 0; j < 8; ++j) gg[j] = p.mem_q_g[d0 + j] * p.mem_k_g[d0 + j] * rq;
                          u32x4 w; w.x = cvt_pk_bf16(bf_lo(raw[ks].x) * gg[0], bf_hi(raw[ks].x) * gg[1]); w.y = cvt_pk_bf16(bf_lo(raw[ks].y) * gg[2], bf_hi(raw[ks].y) * gg[3]);
                          w.z = cvt_pk_bf16(bf_lo(raw[ks].z) * gg[4], bf_hi(raw[ks].z) * gg[5]); w.w = cvt_pk_bf16(bf_lo(raw[ks].w) * gg[6], bf_hi(raw[ks].w) * gg[7]);
                          qf[ks] = __builtin_bit_cast(bf16x8, w); } }
                    f32x4 S[16];
#pragma unroll
                    for (int kb = 0; kb < 16; ++kb) { S[kb] = (f32x4){0.f, 0.f, 0.f, 0.f};
#pragma unroll
                        for (int ks = 0; ks < 4; ++ks) { const bf16x8 kf = *(const LAS bf16x8*)(Ks + (kb * 16 + q16) * KP + ks * 64 + g4 * 16); S[kb] = MFMA16(kf, qf[ks], S[kb]); }
                        const f32x4 rk4 = *(const LAS f32x4*)(rsk + kb * 16 + 4 * g4); S[kb] *= rk4; __builtin_amdgcn_sched_barrier(0); }
                    float mx = -1e30f;
#pragma unroll
                    for (int kb = 0; kb < 16; ++kb) mx = fmaxf(mx, fmaxf(fmaxf(S[kb][0], S[kb][1]), fmaxf(S[kb][2], S[kb][3])));
                    mx = fmaxf(mx, __shfl_xor(mx, 16)); mx = fmaxf(mx, __shfl_xor(mx, 32));
                    float ps = 0.f;
#pragma unroll
                    for (int kb = 0; kb < 16; ++kb)
#pragma unroll
                        for (int e = 0; e < 4; ++e) { S[kb][e] = __expf(S[kb][e] - mx); ps += S[kb][e]; }
                    ps += __shfl_xor(ps, 16); ps += __shfl_xor(ps, 32);
                    const float il = 1.0f / ps;
                    f32x4 Oa[8];
#pragma unroll
                    for (int db = 0; db < 8; ++db) Oa[db] = (f32x4){0.f, 0.f, 0.f, 0.f};
#pragma unroll
                    for (int kp = 0; kp < 8; ++kp) {
                        u32x4 pw; pw.x = cvt_pk_bf16(S[2 * kp][0], S[2 * kp][1]); pw.y = cvt_pk_bf16(S[2 * kp][2], S[2 * kp][3]); pw.z = cvt_pk_bf16(S[2 * kp + 1][0], S[2 * kp + 1][1]); pw.w = cvt_pk_bf16(S[2 * kp + 1][2], S[2 * kp + 1][3]);
                        const bf16x8 pf = __builtin_bit_cast(bf16x8, pw);
#pragma unroll
                        for (int db = 0; db < 8; ++db) {
                            bf16x8 vf;
#if USE_TR
                            { const int qq = q16 >> 2, pp = q16 & 3;
                              const s16x4 lo4 = __builtin_amdgcn_ds_read_tr16_b64_v4i16((LAS s16x4*)(Vm + (32 * kp + 4 * g4 + qq) * KP + (db * 16 + 4 * pp) * 2));
                              const s16x4 hi4 = __builtin_amdgcn_ds_read_tr16_b64_v4i16((LAS s16x4*)(Vm + (32 * kp + 16 + 4 * g4 + qq) * KP + (db * 16 + 4 * pp) * 2));
                              vf = __builtin_shufflevector(lo4, hi4, 0, 1, 2, 3, 4, 5, 6, 7); }
#else
#pragma unroll
                            for (int j = 0; j < 8; ++j) { const int key = 32 * kp + ((j < 4) ? 0 : 16) + 4 * g4 + (j & 3); vf[j] = *(LAS short*)(Vm + key * KP + (db * 16 + q16) * 2); }
#endif
                            Oa[db] = MFMA16(vf, pf, Oa[db]);
                        }
                        __builtin_amdgcn_sched_barrier(0);
                    }
                    { const rsrc_t ars = mk_rsrc(act);
                      const unsigned o0 = (unsigned)((tok * ACT_LD + 1536 + hm * 128 + ((g4 & 1) ? 16 + 4 * (g4 - 1) : 4 * g4)) * 2);
#pragma unroll
                      for (int dp = 0; dp < 4; ++dp) { const f32x4 oa = Oa[2 * dp] * il, ob = Oa[2 * dp + 1] * il;
                          const auto rx = __builtin_amdgcn_permlane16_swap(cvt_pk_bf16(oa[0], oa[1]), cvt_pk_bf16(ob[0], ob[1]), false, false);
                          const auto ry = __builtin_amdgcn_permlane16_swap(cvt_pk_bf16(oa[2], oa[3]), cvt_pk_bf16(ob[2], ob[3]), false, false);
                          u32x4 w; w.x = rx[0]; w.y = ry[0]; w.z = rx[1]; w.w = ry[1];
                          st16_wt(ars, o0 + dp * 64, w); } }
                }
            }
            __syncthreads();
        }
#endif
    }
    if (BOTH(2)) GRID_SYNC();

    if (IN(3)) for (int rep_ = 0; rep_ < NREP(3); ++rep_) {
        if (rep_) GRID_SYNC();
#ifdef EXP_BRANCH
        constexpr int eoff = (EXP_BRANCH == 0) ? 0 : (EXP_BRANCH == 1) ? 512 : 1536, ek = (EXP_BRANCH == 1) ? 1024 : 512;
        pg8::Gemm g{act + eoff, Wcat + eoff, act, Wcat, ACT_LD, 2048, ek, nullptr, 128, 128};
#else
        pg8::Gemm g{act, Wcat, act, Wcat, ACT_LD, 2048, 2048, pimg, 128, 128};
#endif
        pg8::StaticOrder S; S.init(M, D, G, bid);
        pg8::EpiMerge E{gbuf, merged};
        pg8::gemm_phase<pg8::EpiMerge, pg8::StaticOrder, false, true>(lds, g, S, E);
    }
    if (BOTH(3)) GRID_SYNC();

    if (IN(4)) for (int rep_ = 0; rep_ < NREP(4); ++rep_) {
        if (rep_) GRID_SYNC();
        pg8::Gemm g{merged, WoutT, merged, WoutT, D, D, D, nullptr, 128, 128};
        pg8::StaticOrder S; S.init(M, D, G, bid);
        pg8::EpiWout E{p.x, xmb, ssq, (LAS float*)(lds + 131072)};
        pg8::gemm_phase<pg8::EpiWout, pg8::StaticOrder, true>(lds, g, S, E);
    }
    if (BOTH(4)) GRID_SYNC();

    if (IN(5)) for (int rep_ = 0; rep_ < NREP(5); ++rep_) {
        if (rep_) GRID_SYNC();
        pg8::Gemm g{xmb, W1T, xmb, W1T, D, D, D, nullptr, 128, 128};
        pg8::StaticOrder S; S.init(M, FF, G, bid);
        { volatile LAS int* cpm = (volatile LAS int*)(lds + 131072 + 1024); if (tid == 0) *cpm = -1; __syncthreads(); }
        pg8::EpiFfn1 E{ssq, abuf, (LAS float*)(lds + 131072)};
        pg8::gemm_phase<pg8::EpiFfn1, pg8::StaticOrder, true>(lds, g, S, E);
    }
    if (BOTH(5)) GRID_SYNC();

    if (IN(6)) for (int rep_ = 0; rep_ < NREP(6); ++rep_) {
        if (rep_) GRID_SYNC();
        pg8::Gemm g{abuf, W2T, abuf, W2T, 64, 64, FF, nullptr, (size_t)M * 128, (size_t)D * 128};
        pg8::StaticOrder S; S.init(M, D, G, bid);
        pg8::EpiFfn2 E{xmb, p.out};
        pg8::gemm_phase<pg8::EpiFfn2, pg8::StaticOrder, false>(lds, g, S, E);
    }
#undef IN
#undef BOTH
}

extern "C" void kernel_launch(void* const* d_in, const int* in_sizes, int n_in, void* d_out, int out_size, void* d_ws, size_t ws_size, hipStream_t stream) {
    static int grid = 0;
    if (grid == 0) {
        if (n_in != 19 || out_size != M * D || ws_size < WS_END) { fprintf(stderr, "kernel_launch: unexpected shapes (n_in %d out %d ws %zu)\n", n_in, out_size, ws_size); grid = -1; return; }
        int dev = 0, cus = 0, per_cu = 0;
        hipGetDevice(&dev); hipDeviceGetAttribute(&cus, hipDeviceAttributeMultiprocessorCount, dev);
        hipFuncSetAttribute((const void*)fwd_kernel, hipFuncAttributeMaxDynamicSharedMemorySize, LDS_BYTES);
        hipOccupancyMaxActiveBlocksPerMultiprocessor(&per_cu, (const void*)fwd_kernel, 512, LDS_BYTES);
        if (per_cu < 1) { fprintf(stderr, "kernel_launch: occupancy query says %d blocks/CU\n", per_cu); per_cu = 1; }
        (void)hipGetLastError();
        grid = cus * per_cu;
    }
    if (grid < 0) return;
    Params p{};
    p.x = (const float*)d_in[0]; p.mem = (const float*)d_in[1]; p.norm1_g = (const float*)d_in[2]; p.w_in = (const float*)d_in[3]; p.b_gate = (const float*)d_in[4];
    p.na_q_g = (const float*)d_in[5]; p.na_k_g = (const float*)d_in[6]; p.na_rpb = (const float*)d_in[7]; p.w_na_o = (const float*)d_in[8]; p.w_f = (const float*)d_in[9];
    p.mem_norm_g = (const float*)d_in[10]; p.w_mem_kv = (const float*)d_in[11]; p.mem_q_g = (const float*)d_in[12]; p.mem_k_g = (const float*)d_in[13]; p.w_mem_o = (const float*)d_in[14];
    p.w_out = (const float*)d_in[15]; p.norm2_g = (const float*)d_in[16]; p.w_ff1 = (const float*)d_in[17]; p.w_ff2 = (const float*)d_in[18];
    p.out = (float*)d_out; p.ws = (unsigned char*)d_ws;
#if MK_N_LAUNCHES == 1
    (void)hipMemsetAsync((char*)d_ws + WS_BAR, 0, XCD_BAR_WORDS * 4, stream);
    p.ph_lo = 0; p.ph_hi = 7;
    void* args[] = {&p};
    hipError_t e = hipLaunchCooperativeKernel((const void*)fwd_kernel, dim3(grid), dim3(512), args, LDS_BYTES, stream);
    if (e != hipSuccess) fprintf(stderr, "cooperative launch failed: %s (grid %d)\n", hipGetErrorString(e), grid);
#else
    for (int ph = 0; ph < 7; ++ph) { p.ph_lo = ph; p.ph_hi = ph + 1; hipLaunchKernelGGL(fwd_kernel, dim3(grid), dim3(512), LDS_BYTES, stream, p); }
#endif
}
```

```cpp
#include <hip/hip_runtime.h>
#include <hip/hip_cooperative_groups.h>
#include <cstdio>
#include <cstdint>
namespace cg = cooperative_groups;

#ifndef MK_N_LAUNCHES
#define MK_N_LAUNCHES 1
#endif
#ifndef DUP_PHASE
#define DUP_PHASE -1
#endif
#define NREP(k) (((k) == DUP_PHASE) ? 2 : 1)
#define DUP_MIX -1
#ifndef USE_TR
#define USE_TR 1
#endif

#define LAS __attribute__((address_space(3)))
typedef unsigned short bf16_t;
typedef short bf16x8 __attribute__((ext_vector_type(8)));
typedef short s16x4 __attribute__((ext_vector_type(4)));
typedef float f32x4 __attribute__((ext_vector_type(4)));
typedef unsigned u32x4 __attribute__((ext_vector_type(4)));
typedef unsigned u32x2 __attribute__((ext_vector_type(2)));

constexpr int D = 1024, BATCH = 4, SEQ = 4096, M = BATCH * SEQ, NIN = 5632, NZ = 2560, NG = 3072, FF = 4096, MEMT = 256, MROWS = BATCH * MEMT;
constexpr int OFF_Q = 0, OFF_K = 512, OFF_V = 1024, OFF_F = 1536, OFF_MQ = 2048;
constexpr int ACT_LD = 2048;
constexpr float EPS = 1e-6f;
constexpr size_t MiB = 1u << 20;
constexpr size_t WS_WIN = 0, WS_WKV = 11 * MiB, WS_WCAT = 13 * MiB, WS_WOUT = 17 * MiB, WS_W1 = 19 * MiB, WS_W2 = 27 * MiB, WS_TAB = 35 * MiB,
                 WS_BAR = 35 * MiB + 512 * 1024, WS_NSHIFT = 35 * MiB + 768 * 1024, WS_FUT = 124 * MiB, WS_MEMN = 36 * MiB, WS_MEMKV = 38 * MiB, WS_SSQ = 40 * MiB, WS_G = 44 * MiB, WS_Z = 140 * MiB, WS_H = 220 * MiB,
                 WS_MERGED = 140 * MiB, WS_XMB = 172 * MiB, WS_A = 44 * MiB, WS_END = 256 * MiB;
constexpr int LDS_BYTES = 147456;

typedef float f32x2_t __attribute__((ext_vector_type(2))); typedef __bf16 bf16x2_t __attribute__((ext_vector_type(2)));
__device__ __forceinline__ unsigned cvt_pk_bf16(float lo, float hi) { f32x2_t v = {lo, hi}; bf16x2_t b = __builtin_convertvector(v, bf16x2_t); return __builtin_bit_cast(unsigned, b); }
__device__ __forceinline__ float bf_lo(unsigned w) { return __uint_as_float(w << 16); }
__device__ __forceinline__ float bf_hi(unsigned w) { return __uint_as_float(w & 0xffff0000u); }
__device__ __forceinline__ float bf2f(bf16_t h) { return __uint_as_float(((unsigned)h) << 16); }
__device__ __forceinline__ float wave_sum(float v) {
#pragma unroll
    for (int o = 1; o < 64; o <<= 1) v += __shfl_xor(v, o);
    return v;
}
__device__ __forceinline__ float cosrev(float r) { return __builtin_amdgcn_cosf(r); }
__device__ __forceinline__ float sinrev(float r) { return __builtin_amdgcn_sinf(r); }
typedef __amdgpu_buffer_rsrc_t rsrc_t;
__device__ __forceinline__ rsrc_t mk_rsrc(const void* p) { return __builtin_amdgcn_make_buffer_rsrc((void*)p, 0, 0x7fffffff, 0x00020000); }
__device__ __forceinline__ void st16_wt(rsrc_t r, unsigned byte_off, u32x4 v) { __builtin_amdgcn_raw_buffer_store_b128(v, r, byte_off, 0, 16); }
#define MFMA16(a, b, c) __builtin_amdgcn_mfma_f32_16x16x32_bf16((a), (b), (c), 0, 0, 0)

namespace pg8 {
constexpr int BM = 256, BK = 64, HALF = 128, HTB = HALF * BK * 2, STAGE_BYTES = 8 * HTB, NXCD = 8, WGM = 8;
__host__ __device__ __forceinline__ int lds_byte(int r, int c) { const int st = (r >> 4) * 2 + (c >> 5), rr = r & 15, cc = c & 31, ob = rr * 64 + cc * 2; return st * 1024 + (ob ^ (((ob >> 9) & 1) << 5)); }
__host__ __device__ __forceinline__ void stage_rc(int b, int& R, int& C) { const int st = b / 1024, sb = b % 1024, swz = sb ^ (((sb >> 9) & 1) << 5); R = (st >> 1) * 16 + swz / 64; C = (st & 1) * 32 + (swz % 64) / 2; }
__host__ __device__ __forceinline__ int perm32(int rho) { const int n = rho >> 4, i = rho & 15; return 8 * (i >> 2) + 4 * n + (i & 3); }

struct Unit { int pm, pn, z; };
struct Gemm { const bf16_t* A0; const bf16_t* B0; const bf16_t* A1; const bf16_t* B1; int lda, ldb, K; const bf16_t* P2; size_t kstepA, kstepB; };

struct StaticOrder {
    int nM, nN, nwg, G, c;
    __device__ void init(int M_, int N_, int G_, int c_) { nM = M_ / BM; nN = N_ / BM; nwg = nM * nN; G = G_; c = c_; }
    __device__ __forceinline__ void map(int wgid, Unit& u) const {
        { const int q = nwg / NXCD, r = nwg % NXCD, xcd = wgid % NXCD, off = wgid / NXCD; wgid = (xcd < r ? xcd * (q + 1) : r * (q + 1) + (xcd - r) * q) + off; }
        const int nig = WGM * nN, gid = wgid / nig, fm = gid * WGM, gsz = (nM - fm) < WGM ? (nM - fm) : WGM;
        u.pm = fm + ((wgid % nig) % gsz); u.pn = (wgid % nig) / gsz; u.z = 0;
    }
    __device__ bool next(int i, Unit& u) const { const long L = (long)i * G + c; if (L >= nwg) return false; map((int)L, u); return true; }
};
struct ComboOrder {
    StaticOrder s; int extra, extra_nn, rot;
    __device__ bool next(int i, Unit& u) const {
        const long L = (long)i * s.G + s.c; if (L >= s.nwg + extra) return false;
        if (L < s.nwg) { s.map((int)L, u); u.pn = (u.pn + rot) % s.nN; } else { const int e = (int)L - s.nwg; u.pm = e / extra_nn; u.pn = e % extra_nn; u.z = 1; }
        return true;
    }
};

template <class Epi, class Sched, bool ALIGN_EPI, bool SEGA = false>
__device__ __forceinline__ void gemm_phase(LAS unsigned char* lds, const Gemm g, const Sched& S, const Epi& E) {
    const int tid = threadIdx.x, wid = __builtin_amdgcn_readfirstlane(tid >> 6), lane = tid & 63, wr = wid >> 2, wc = wid & 3, fr = lane & 15, fq = lane >> 4;
    const int K = g.K, nt = K / BK;
    unsigned voffA[2], voffB[2], voffA2[2];
#pragma unroll
    for (int i = 0; i < 2; ++i) { int R, C; stage_rc(tid * 16 + i * 8192, R, C); const int Rb = Epi::PERM ? ((R & ~31) + perm32(R & 31)) : R;
        voffA[i] = (unsigned)(R * g.lda + C) * 2u; voffB[i] = (unsigned)(Rb * g.ldb + C) * 2u; voffA2[i] = (unsigned)((C >> 3) * 4096 + R) * 16u; }
    const size_t kstep = g.kstepA, kstepB = g.kstepB;
    const size_t hstepA = (size_t)HALF * g.lda * 2, hstepB = (size_t)HALF * g.ldb * 2;
    const size_t tstepA = 2 * hstepA, tstepB = 2 * hstepB;
    const unsigned ldsw = (unsigned)wid * 1024u;
    const int aoff = lds_byte(wr * 64 + fr, fq * 8), boff = lds_byte(wc * 32 + fr, fq * 8);
#define PG8_SA(b, h) (((b) * 2 + (h)) * HTB)
#define PG8_SB(b, h) ((4 + (b) * 2 + (h)) * HTB)
#define PG8_STAGE(bufoff, gbase, voff) do { _Pragma("unroll") for (int _i = 0; _i < 2; ++_i) \
        __builtin_amdgcn_global_load_lds((const unsigned*)((const char*)(gbase) + (voff)[_i]), (LAS unsigned*)(lds + (bufoff) + ldsw + _i * 8192), 16, 0, 0); } while (0)
#define PG8_ASTAGE(bufoff, uA, uP, tile, half) do { const int tl_ = (tile); const char* gp_; unsigned o0_, o1_; \
        if (SEGA && (unsigned)(tl_ - 8) < 16u) { gp_ = (uP) + (size_t)(tl_ - 8) * 524288 + (half) * 2048; o0_ = voffA2[0]; o1_ = voffA2[1]; } \
        else { gp_ = (uA) + (size_t)tl_ * kstep + (size_t)(half) * hstepA; o0_ = voffA[0]; o1_ = voffA[1]; } \
        __builtin_amdgcn_global_load_lds((const unsigned*)(gp_ + o0_), (LAS unsigned*)(lds + (bufoff) + ldsw), 16, 0, 0); \
        __builtin_amdgcn_global_load_lds((const unsigned*)(gp_ + o1_), (LAS unsigned*)(lds + (bufoff) + ldsw + 8192), 16, 0, 0); } while (0)
#define PG8_UP2(pm_) ((const char*)g.P2 + ((size_t)((pm_) >> 4) * 128 * 4096 + (size_t)((pm_) & 15) * 256) * 16)
#define PG8_LDA(dst, b, h) do { _Pragma("unroll") for (int m = 0; m < 4; ++m) _Pragma("unroll") for (int k = 0; k < 2; ++k) dst[m][k] = *(const LAS bf16x8*)(lds + PG8_SA(b, h) + aoff + m * 2048 + k * 1024); } while (0)
#define PG8_LDB(dst, b, h) do { _Pragma("unroll") for (int n = 0; n < 2; ++n) _Pragma("unroll") for (int k = 0; k < 2; ++k) dst[n][k] = *(const LAS bf16x8*)(lds + PG8_SB(b, h) + boff + n * 2048 + k * 1024); } while (0)
#define PG8_MMA(ai, bj, At, Bt) do { __builtin_amdgcn_s_setprio(1); _Pragma("unroll") for (int m = 0; m < 4; ++m) _Pragma("unroll") for (int n = 0; n < 2; ++n) _Pragma("unroll") for (int k = 0; k < 2; ++k) \
        acc[ai][bj][m][n] = __builtin_amdgcn_mfma_f32_16x16x32_bf16(Bt[n][k], At[m][k], acc[ai][bj][m][n], 0, 0, 0); __builtin_amdgcn_s_setprio(0); } while (0)
#define PG8_WAIT_V(n) asm volatile("s_waitcnt vmcnt(" #n ")" ::: "memory")
#define PG8_WAIT_L(n) asm volatile("s_waitcnt lgkmcnt(" #n ")" ::: "memory")
#define PG8_BAR __builtin_amdgcn_s_barrier()
#define PG8_SCHED __builtin_amdgcn_sched_barrier(0)
    Unit cur, nxt; int ui = 0;
    if (!S.next(0, cur)) return;
    f32x4 acc[2][2][4][2];
#pragma unroll
    for (int a = 0; a < 2; ++a)
#pragma unroll
        for (int b = 0; b < 2; ++b)
#pragma unroll
            for (int m = 0; m < 4; ++m)
#pragma unroll
                for (int n = 0; n < 2; ++n) acc[a][b][m][n] = (f32x4){0.f, 0.f, 0.f, 0.f};
    bf16x8 At[4][2], B0[2][2], B1[2][2];
    const char* cA = (const char*)(cur.z ? g.A1 : g.A0) + (size_t)cur.pm * tstepA; const char* cB = (const char*)(cur.z ? g.B1 : g.B0) + (size_t)cur.pn * tstepB;
    const char* cP = SEGA ? PG8_UP2(cur.pm) : nullptr;
    PG8_STAGE(PG8_SB(0, 0), cB, voffB); PG8_STAGE(PG8_SB(0, 1), cB + hstepB, voffB); PG8_ASTAGE(PG8_SA(0, 0), cA, cP, 0, 0); PG8_ASTAGE(PG8_SA(0, 1), cA, cP, 0, 1);
    if (wr == 1) PG8_BAR;
    PG8_WAIT_V(2); PG8_BAR;
    PG8_STAGE(PG8_SB(1, 0), cB + kstepB, voffB); PG8_ASTAGE(PG8_SA(1, 0), cA, cP, 1, 0); PG8_STAGE(PG8_SB(1, 1), cB + hstepB + kstepB, voffB);
    PG8_WAIT_V(6); PG8_BAR;
    for (;;) {
        const bool has_next = S.next(ui + 1, nxt);
        const char* nA = has_next ? (const char*)(nxt.z ? g.A1 : g.A0) + (size_t)nxt.pm * tstepA : cA; const char* nB = has_next ? (const char*)(nxt.z ? g.B1 : g.B0) + (size_t)nxt.pn * tstepB : cB;
        const char* nP = (SEGA && has_next) ? PG8_UP2(nxt.pm) : cP;
        for (int t = 0; t < nt; t += 2) {
            if constexpr (Epi::HAS_MID) E.mid(acc, cur, t, wr, wc, fr, fq);
            const bool last = (t == nt - 2);
            const char* uA2 = last ? nA : cA; const char* uP2 = last ? nP : cP; const int t2 = last ? 0 : t + 2;
            const char* b2 = last ? nB : cB + (size_t)(t + 2) * kstepB; const char* b3 = b2 + kstepB;
            PG8_LDB(B0, 0, 0); PG8_LDB(B1, 0, 1); PG8_SCHED; PG8_LDA(At, 0, 0); PG8_ASTAGE(PG8_SA(1, 1), cA, cP, t + 1, 1);
            PG8_WAIT_V(8); PG8_WAIT_L(0); PG8_BAR; PG8_MMA(0, 0, At, B0); PG8_MMA(0, 1, At, B1); PG8_BAR; PG8_SCHED;
            PG8_LDA(At, 0, 1); PG8_STAGE(PG8_SB(0, 0), b2, voffB); PG8_STAGE(PG8_SB(0, 1), b2 + hstepB, voffB); PG8_ASTAGE(PG8_SA(0, 0), uA2, uP2, t2, 0);
            PG8_WAIT_V(8); PG8_WAIT_L(0); PG8_BAR; PG8_MMA(1, 0, At, B0); PG8_MMA(1, 1, At, B1); PG8_BAR; PG8_SCHED;
            PG8_LDB(B0, 1, 0); PG8_LDB(B1, 1, 1); PG8_SCHED; PG8_LDA(At, 1, 0); PG8_ASTAGE(PG8_SA(0, 1), uA2, uP2, t2, 1);
            PG8_WAIT_V(8); PG8_WAIT_L(0); PG8_BAR; PG8_MMA(0, 0, At, B0); PG8_MMA(0, 1, At, B1); PG8_BAR; PG8_SCHED;
            PG8_LDA(At, 1, 1); PG8_STAGE(PG8_SB(1, 0), b3, voffB); PG8_STAGE(PG8_SB(1, 1), b3 + hstepB, voffB); PG8_ASTAGE(PG8_SA(1, 0), uA2, uP2, t2 + 1, 0);
            PG8_WAIT_V(8); PG8_WAIT_L(0); PG8_BAR; PG8_MMA(1, 0, At, B0); PG8_MMA(1, 1, At, B1); PG8_BAR; PG8_SCHED;
        }
        if constexpr (ALIGN_EPI) { if (wr == 0) PG8_BAR; }
        E(acc, cur, wr, wc, fr, fq);
        if (!has_next) break;
#pragma unroll
        for (int a = 0; a < 2; ++a)
#pragma unroll
            for (int b = 0; b < 2; ++b)
#pragma unroll
                for (int m = 0; m < 4; ++m)
#pragma unroll
                    for (int n = 0; n < 2; ++n) acc[a][b][m][n] = (f32x4){0.f, 0.f, 0.f, 0.f};
        cur = nxt; cA = nA; cB = nB; cP = nP; ++ui;
        if constexpr (ALIGN_EPI) { if (wr == 1) PG8_BAR; }
    }
    PG8_WAIT_V(0);
    if constexpr (!ALIGN_EPI) { if (wr == 0) PG8_BAR; }
    PG8_BAR;
#undef PG8_SA
#undef PG8_SB
#undef PG8_STAGE
#undef PG8_LDA
#undef PG8_ASTAGE
#undef PG8_UP2
#undef PG8_LDB
#undef PG8_MMA
#undef PG8_WAIT_V
#undef PG8_WAIT_L
#undef PG8_BAR
#undef PG8_SCHED
}

typedef f32x4 Acc[2][2][4][2];

struct EpiInProj {
    static constexpr bool PERM = true, HAS_MID = false;
    bf16_t* Z; unsigned char* G; bf16_t* MKV; const float* bgate; const float* gq; const float* gk; LAS float* P; bf16_t* FUT;
    __device__ __forceinline__ void operator()(const Acc& acc, const Unit& u, int wr, int wc, int fr, int fq) const {
        const int row0 = u.pm * BM + wr * 64 + fr;
        if (u.z == 0 && u.pn >= NZ / BM) {
            const int col0 = (u.pn - NZ / BM) * BM + wc * 32 + 8 * fq;
            const float NL2E = -1.4426950408889634f, I255 = 1.0f / 255.0f;
            const int gtile = u.pn - NZ / BM;
            unsigned char* gt = G + ((size_t)(((gtile >> 2) * (M / BM) + u.pm) * 4 + (gtile & 3)) * 8 + (wr * 4 + wc)) * 8192 + (fq * 16 + fr) * 16;
            f32x4 bv[2][2];
#pragma unroll
            for (int bj = 0; bj < 2; ++bj)
#pragma unroll
                for (int n = 0; n < 2; ++n) bv[bj][n] = *(const f32x4*)(bgate + col0 + bj * HALF + 4 * n) * NL2E;
#pragma unroll
            for (int ai = 0; ai < 2; ++ai)
#pragma unroll
                for (int m = 0; m < 4; ++m) { u32x4 w16;
#pragma unroll
                    for (int bj = 0; bj < 2; ++bj) { u32x2 w; w.x = 0u; w.y = 0u;
#pragma unroll
                        for (int e = 0; e < 4; ++e) {
                            const float q0 = __builtin_rintf(fmaxf(__builtin_amdgcn_rcpf(fmaf(__builtin_amdgcn_exp2f(fmaf(acc[ai][bj][m][0][e], NL2E, bv[bj][0][e])), I255, I255)), 1.0f));
                            const float q1 = __builtin_rintf(fmaxf(__builtin_amdgcn_rcpf(fmaf(__builtin_amdgcn_exp2f(fmaf(acc[ai][bj][m][1][e], NL2E, bv[bj][1][e])), I255, I255)), 1.0f));
                            w.x = __builtin_amdgcn_cvt_pk_u8_f32(q0, e, w.x); w.y = __builtin_amdgcn_cvt_pk_u8_f32(q1, e, w.y); }
                        if (bj == 0) { w16.x = w.x; w16.y = w.y; } else { w16.z = w.x; w16.w = w.y; } }
                    *(u32x4*)(gt + (ai * 4 + m) * 1024) = w16; }
            return;
        }
        if (u.z == 0 && (u.pn == 6 || u.pn == 7)) {
            const int ch0 = (u.pn - 6) * BM + wc * 32 + 8 * fq;
#pragma unroll
            for (int ai = 0; ai < 2; ++ai)
#pragma unroll
                for (int m = 0; m < 4; ++m) { const int row = row0 + ai * HALF + m * 16, bb = row >> 12, tok = row & 4095;
#pragma unroll
                    for (int bj = 0; bj < 2; ++bj) { const f32x4 v0 = acc[ai][bj][m][0], v1 = acc[ai][bj][m][1]; const int cb0 = (ch0 + bj * HALF) >> 2;
                        u32x2 w0, w1; w0.x = cvt_pk_bf16(v0[0], v0[1]); w0.y = cvt_pk_bf16(v0[2], v0[3]); w1.x = cvt_pk_bf16(v1[0], v1[1]); w1.y = cvt_pk_bf16(v1[2], v1[3]);
                        *(u32x2*)(FUT + (((size_t)(bb * 128 + cb0) * 4096 + tok) * 4)) = w0; *(u32x2*)(FUT + (((size_t)(bb * 128 + cb0 + 1) * 4096 + tok) * 4)) = w1; } }
            return;
        }
        bf16_t* base; int ldc;
        if (u.z == 1) { base = MKV; ldc = D; } else { base = Z; ldc = NZ; }
        const int col0 = u.pn * BM + wc * 32 + 8 * fq;
        const bool qk = (u.z == 0) && (u.pn < 4);
        float rsn[2][4][2]; f32x4 g0 = (f32x4){1.f, 1.f, 1.f, 1.f}, g1 = g0;
        if (qk) {
#pragma unroll
            for (int ai = 0; ai < 2; ++ai)
#pragma unroll
                for (int m = 0; m < 4; ++m)
#pragma unroll
                    for (int bj = 0; bj < 2; ++bj) { const f32x4 a0 = acc[ai][bj][m][0], a1 = acc[ai][bj][m][1];
                        float ss = ((a0[0] * a0[0] + a0[1] * a0[1]) + (a0[2] * a0[2] + a0[3] * a0[3])) + ((a1[0] * a1[0] + a1[1] * a1[1]) + (a1[2] * a1[2] + a1[3] * a1[3]));
                        ss += __shfl_xor(ss, 16); ss += __shfl_xor(ss, 32);
                        if (fq == 0) P[(((ai * HALF + wr * 64 + m * 16 + fr) * 4 + 2 * bj + (wc >> 1)) * 2) + (wc & 1)] = ss; }
            asm volatile("s_waitcnt lgkmcnt(0)" ::: "memory"); __builtin_amdgcn_s_barrier(); asm volatile("" ::: "memory");
#pragma unroll
            for (int ai = 0; ai < 2; ++ai)
#pragma unroll
                for (int m = 0; m < 4; ++m)
#pragma unroll
                    for (int bj = 0; bj < 2; ++bj) { const LAS float* pp = P + (((ai * HALF + wr * 64 + m * 16 + fr) * 4 + 2 * bj + (wc >> 1)) * 2);
                        rsn[ai][m][bj] = rsqrtf((pp[0] + pp[1]) * (1.0f / 64.0f) + EPS); }
            if (u.pn < 2) { const int d0 = 32 * (wc & 1) + 8 * fq; const float sc = 0.125f * 1.4426950408889634f;
#pragma unroll
                for (int e = 0; e < 4; ++e) { g0[e] = gq[d0 + e] * gk[d0 + e] * sc; g1[e] = gq[d0 + 4 + e] * gk[d0 + 4 + e] * sc; } }
        } else {
#pragma unroll
            for (int ai = 0; ai < 2; ++ai)
#pragma unroll
                for (int m = 0; m < 4; ++m) { rsn[ai][m][0] = 1.f; rsn[ai][m][1] = 1.f; }
        }
#pragma unroll
        for (int ai = 0; ai < 2; ++ai)
#pragma unroll
            for (int m = 0; m < 4; ++m) { const unsigned ro = (unsigned)((row0 + ai * HALF + m * 16) * ldc + col0) * 2u;
#pragma unroll
                for (int bj = 0; bj < 2; ++bj) { const f32x4 v0 = acc[ai][bj][m][0] * rsn[ai][m][bj] * g0, v1 = acc[ai][bj][m][1] * rsn[ai][m][bj] * g1;
                    u32x4 w; w.x = cvt_pk_bf16(v0[0], v0[1]); w.y = cvt_pk_bf16(v0[2], v0[3]); w.z = cvt_pk_bf16(v1[0], v1[1]); w.w = cvt_pk_bf16(v1[2], v1[3]);
                    *(u32x4*)((char*)base + ro + bj * HALF * 2) = w; } }
    }
};

__device__ __forceinline__ float ub0(unsigned w) { return (float)(w & 0xffu); }
__device__ __forceinline__ float ub1(unsigned w) { return (float)((w >> 8) & 0xffu); }
__device__ __forceinline__ float ub2(unsigned w) { return (float)((w >> 16) & 0xffu); }
__device__ __forceinline__ float ub3(unsigned w) { return (float)(w >> 24); }
struct EpiMerge {
    static constexpr bool PERM = true, HAS_MID = true;
    const unsigned char* G; bf16_t* O;
    __device__ __forceinline__ const unsigned char* gimg(const Unit& u, int g, int wr, int wc, int fr, int fq) const {
        return G + ((size_t)((g * (M / BM) + u.pm) * 4 + u.pn) * 8 + (wr * 4 + wc)) * 8192 + (fq * 16 + fr) * 16; }
    __device__ __forceinline__ void rescale(Acc& acc, const Unit& u, int ga, int gb, int wr, int wc, int fr, int fq) const {
        const unsigned char* gpa = gimg(u, ga, wr, wc, fr, fq); const unsigned char* gpb = gimg(u, gb, wr, wc, fr, fq);
#pragma unroll
        for (int ai = 0; ai < 2; ++ai) {
            u32x4 a[4], b[4];
#pragma unroll
            for (int m = 0; m < 4; ++m) { a[m] = *(const u32x4*)(gpa + (ai * 4 + m) * 1024); b[m] = *(const u32x4*)(gpb + (ai * 4 + m) * 1024); }
#pragma unroll
            for (int m = 0; m < 4; ++m)
#pragma unroll
                for (int bj = 0; bj < 2; ++bj) { const unsigned ax = bj ? a[m].z : a[m].x, ay = bj ? a[m].w : a[m].y, bx = bj ? b[m].z : b[m].x, by = bj ? b[m].w : b[m].y;
                    f32x4 r0, r1;
                    r0[0] = ub0(ax) * __builtin_amdgcn_rcpf(ub0(bx)); r0[1] = ub1(ax) * __builtin_amdgcn_rcpf(ub1(bx)); r0[2] = ub2(ax) * __builtin_amdgcn_rcpf(ub2(bx)); r0[3] = ub3(ax) * __builtin_amdgcn_rcpf(ub3(bx));
                    r1[0] = ub0(ay) * __builtin_amdgcn_rcpf(ub0(by)); r1[1] = ub1(ay) * __builtin_amdgcn_rcpf(ub1(by)); r1[2] = ub2(ay) * __builtin_amdgcn_rcpf(ub2(by)); r1[3] = ub3(ay) * __builtin_amdgcn_rcpf(ub3(by));
                    acc[ai][bj][m][0] *= r0; acc[ai][bj][m][1] *= r1; }
            asm volatile("" ::: "memory");
        }
    }
    __device__ __forceinline__ void mid(Acc& acc, const Unit& u, int t, int wr, int wc, int fr, int fq) const {
        if (t == 8 || t == 24) { const int ga = (t == 8) ? 0 : 1; rescale(acc, u, ga, ga + 1, wr, wc, fr, fq); }
    }
    __device__ __forceinline__ void operator()(Acc& acc, const Unit& u, int wr, int wc, int fr, int fq) const {
        const int row0 = u.pm * BM + wr * 64 + fr, col0 = u.pn * BM + wc * 32 + 8 * fq;
        const float k = 1.0f / 255.0f; const rsrc_t ro_rs = mk_rsrc(O);
        const unsigned char* gp2 = gimg(u, 2, wr, wc, fr, fq);
#pragma unroll
        for (int ai = 0; ai < 2; ++ai) {
            u32x4 a[4];
#pragma unroll
            for (int m = 0; m < 4; ++m) a[m] = *(const u32x4*)(gp2 + (ai * 4 + m) * 1024);
#pragma unroll
            for (int m = 0; m < 4; ++m) { const unsigned ro = (unsigned)((row0 + ai * HALF + m * 16) * D + col0) * 2u;
#pragma unroll
                for (int bj = 0; bj < 2; ++bj) { const unsigned ax = bj ? a[m].z : a[m].x, ay = bj ? a[m].w : a[m].y; const f32x4 v0 = acc[ai][bj][m][0] * k, v1 = acc[ai][bj][m][1] * k;
                    u32x4 w; w.x = cvt_pk_bf16(v0[0] * ub0(ax), v0[1] * ub1(ax)); w.y = cvt_pk_bf16(v0[2] * ub2(ax), v0[3] * ub3(ax));
                    w.z = cvt_pk_bf16(v1[0] * ub0(ay), v1[1] * ub1(ay)); w.w = cvt_pk_bf16(v1[2] * ub2(ay), v1[3] * ub3(ay));
                    st16_wt(ro_rs, ro + bj * HALF * 2, w); } }
            asm volatile("" ::: "memory");
        }
    }
};

struct EpiWout {
    static constexpr bool PERM = true, HAS_MID = false;
    const float* X; bf16_t* XMB; float* SSQ; LAS float* P;
    __device__ __forceinline__ void operator()(const Acc& acc, const Unit& u, int wr, int wc, int fr, int fq) const {
        const int col0 = u.pn * BM + wc * 32 + 8 * fq; const rsrc_t xrs = mk_rsrc(XMB);
#pragma unroll
        for (int ai = 0; ai < 2; ++ai) {
            f32x4 xv[4][2][2];
#pragma unroll
            for (int m = 0; m < 4; ++m)
#pragma unroll
                for (int bj = 0; bj < 2; ++bj)
#pragma unroll
                    for (int n = 0; n < 2; ++n) xv[m][bj][n] = __builtin_nontemporal_load((const f32x4*)(X + (size_t)(u.pm * BM + ai * HALF + wr * 64 + m * 16 + fr) * D + col0 + bj * HALF + n * 4));
#pragma unroll
            for (int m = 0; m < 4; ++m) { const int rl = ai * HALF + wr * 64 + m * 16 + fr; const unsigned ro = (unsigned)((u.pm * BM + rl) * D + col0) * 2u; float s = 0.f;
#pragma unroll
                for (int bj = 0; bj < 2; ++bj) { const f32x4 o0 = xv[m][bj][0] + acc[ai][bj][m][0], o1 = xv[m][bj][1] + acc[ai][bj][m][1];
                    u32x4 w; w.x = cvt_pk_bf16(o0[0], o0[1]); w.y = cvt_pk_bf16(o0[2], o0[3]); w.z = cvt_pk_bf16(o1[0], o1[1]); w.w = cvt_pk_bf16(o1[2], o1[3]);
                    st16_wt(xrs, ro + bj * HALF * 2, w);
                    s += ((o0[0] * o0[0] + o0[1] * o0[1]) + (o0[2] * o0[2] + o0[3] * o0[3])) + ((o1[0] * o1[0] + o1[1] * o1[1]) + (o1[2] * o1[2] + o1[3] * o1[3])); }
                s += __shfl_xor(s, 16); s += __shfl_xor(s, 32);
                if (fq == 0) P[rl * 4 + wc] = s; }
            asm volatile("" ::: "memory");
        }
        asm volatile("s_waitcnt lgkmcnt(0)" ::: "memory"); __builtin_amdgcn_s_barrier(); asm volatile("" ::: "memory");
        const int t = threadIdx.x;
        if (t < 256) { const f32x4 pv = *(const LAS f32x4*)(P + t * 4); SSQ[(size_t)(u.pm * BM + t) * 4 + u.pn] = (pv[0] + pv[1]) + (pv[2] + pv[3]); }
        asm volatile("s_waitcnt lgkmcnt(0)" ::: "memory"); __builtin_amdgcn_s_barrier(); asm volatile("" ::: "memory");
    }
};

struct EpiFfn1 {
    static constexpr bool PERM = true, HAS_MID = false;
    const float* SSQ; bf16_t* O; LAS float* RS;
    __device__ __forceinline__ void operator()(const Acc& acc, const Unit& u, int wr, int wc, int fr, int fq) const {
        volatile LAS int* cpm = (volatile LAS int*)(RS + 256);
        if (*cpm != u.pm) {
            __builtin_amdgcn_s_barrier();
            const int t = threadIdx.x;
            if (t < 256) { const f32x4 s4 = *(const f32x4*)(SSQ + (size_t)(u.pm * BM + t) * 4); RS[t] = rsqrtf(((s4[0] + s4[1]) + (s4[2] + s4[3])) * (1.0f / D) + EPS); }
            if (t == 0) *cpm = u.pm;
            asm volatile("s_waitcnt vmcnt(0) lgkmcnt(0)" ::: "memory"); __builtin_amdgcn_s_barrier(); asm volatile("" ::: "memory");
        }
        const int rl0 = wr * 64 + fr, col0 = u.pn * BM + wc * 32 + 8 * fq; const rsrc_t ors = mk_rsrc(O);
#pragma unroll
        for (int ai = 0; ai < 2; ++ai)
#pragma unroll
            for (int m = 0; m < 4; ++m) { const int rl = rl0 + ai * HALF + m * 16, row = u.pm * BM + rl; const float rs = RS[rl];
                const unsigned ro = (unsigned)((((size_t)(col0 >> 6) * M + row) * 64 + (col0 & 63)) * 2);
#pragma unroll
                for (int bj = 0; bj < 2; ++bj) { f32x4 v0 = acc[ai][bj][m][0] * rs, v1 = acc[ai][bj][m][1] * rs;
#pragma unroll
                    for (int e = 0; e < 4; ++e) { const float a = fmaxf(v0[e], 0.f), b = fmaxf(v1[e], 0.f); v0[e] = a * a; v1[e] = b * b; }
                    u32x4 w; w.x = cvt_pk_bf16(v0[0], v0[1]); w.y = cvt_pk_bf16(v0[2], v0[3]); w.z = cvt_pk_bf16(v1[0], v1[1]); w.w = cvt_pk_bf16(v1[2], v1[3]);
                    st16_wt(ors, ro + (unsigned)bj * (2u * M * 64u * 2u), w); } }
    }
};

struct EpiFfn2 {
    static constexpr bool PERM = false, HAS_MID = false;
    const bf16_t* XMB; float* O;
    __device__ __forceinline__ void operator()(const Acc& acc, const Unit& u, int wr, int wc, int fr, int fq) const {
        const int col0 = u.pn * BM + wc * 32 + 4 * fq;
        u32x2 xb[2][4][2][2];
#pragma unroll
        for (int ai = 0; ai < 2; ++ai)
#pragma unroll
            for (int m = 0; m < 4; ++m) { const size_t off = (size_t)(u.pm * BM + ai * HALF + wr * 64 + m * 16 + fr) * D + col0;
#pragma unroll
                for (int bj = 0; bj < 2; ++bj)
#pragma unroll
                    for (int n = 0; n < 2; ++n) xb[ai][m][bj][n] = *(const u32x2*)(XMB + off + bj * HALF + n * 16); }
#pragma unroll
        for (int ai = 0; ai < 2; ++ai)
#pragma unroll
            for (int m = 0; m < 4; ++m) { const size_t off = (size_t)(u.pm * BM + ai * HALF + wr * 64 + m * 16 + fr) * D + col0;
#pragma unroll
                for (int bj = 0; bj < 2; ++bj)
#pragma unroll
                    for (int n = 0; n < 2; ++n) { const u32x2 w = xb[ai][m][bj][n];
                        f32x4 xv; xv[0] = bf_lo(w.x); xv[1] = bf_hi(w.x); xv[2] = bf_lo(w.y); xv[3] = bf_hi(w.y);
                        *(f32x4*)(O + off + bj * HALF + n * 16) = xv + acc[ai][bj][m][n]; } }
    }
};
}

struct Params {
    const float *x, *mem, *norm1_g, *w_in, *b_gate, *na_q_g, *na_k_g, *na_rpb, *w_na_o, *w_f, *mem_norm_g, *w_mem_kv, *mem_q_g, *mem_k_g, *w_mem_o, *w_out, *norm2_g, *w_ff1, *w_ff2;
    float* out; unsigned char* ws; int ph_lo, ph_hi;
};

__device__ __forceinline__ unsigned f2bf(float f) { unsigned u = __builtin_bit_cast(unsigned, f); return (u + 0x7fffu + ((u >> 16) & 1u)) >> 16; }
__device__ __forceinline__ unsigned pk2(float lo, float hi) { return f2bf(lo) | (f2bf(hi) << 16); }

__device__ __forceinline__ void p0_transpose_item(const float* W, int N, bf16_t* WT, int ldo, int col_off, const float* kscale, LAS float* scr, int item, int lane, size_t ktstride = 0) {
    const int nblk = N / 32, kb = item / nblk, nb = item % nblk, k0 = 64 * kb, n0 = 32 * nb;
    f32x4 v[8];
#pragma unroll
    for (int i = 0; i < 8; ++i) { const int kk = i * 8 + (lane >> 3); v[i] = *(const f32x4*)(W + (size_t)(k0 + kk) * N + n0 + (lane & 7) * 4); }
#pragma unroll
    for (int i = 0; i < 8; ++i) { const int kk = i * 8 + (lane >> 3); const float sc = kscale ? kscale[k0 + kk] : 1.0f; LAS float* d = scr + kk * 33 + (lane & 7) * 4;
        d[0] = v[i][0] * sc; d[1] = v[i][1] * sc; d[2] = v[i][2] * sc; d[3] = v[i][3] * sc; }
    asm volatile("s_waitcnt lgkmcnt(0)" ::: "memory");
    const int c = lane & 7;
#pragma unroll
    for (int j = 0; j < 4; ++j) { const int n = (lane >> 3) + 8 * j; const LAS float* s = scr + (8 * c) * 33 + n;
        u32x4 o; o.x = pk2(s[0 * 33], s[1 * 33]); o.y = pk2(s[2 * 33], s[3 * 33]); o.z = pk2(s[4 * 33], s[5 * 33]); o.w = pk2(s[6 * 33], s[7 * 33]);
        bf16_t* dp = ktstride ? (WT + (size_t)kb * ktstride + (size_t)(n0 + n) * 64 + 8 * c) : (WT + (size_t)(n0 + n) * ldo + col_off + k0 + 8 * c);
        *(u32x4*)dp = o; }
    asm volatile("s_waitcnt lgkmcnt(0)" ::: "memory");
}
__device__ __forceinline__ void rms_rows4_to_bf16(const float* xrow, const float* gvec, bf16_t* orow, int lane) {
    const f32x4* gr = (const f32x4*)gvec + lane;
    f32x4 v[4][4]; float s[4];
#pragma unroll
    for (int r = 0; r < 4; ++r)
#pragma unroll
        for (int j = 0; j < 4; ++j) v[r][j] = __builtin_nontemporal_load((const f32x4*)(xrow + (size_t)r * D) + lane + 64 * j);
#pragma unroll
    for (int r = 0; r < 4; ++r) { s[r] = 0.f;
#pragma unroll
        for (int j = 0; j < 4; ++j) s[r] += (v[r][j][0] * v[r][j][0] + v[r][j][1] * v[r][j][1]) + (v[r][j][2] * v[r][j][2] + v[r][j][3] * v[r][j][3]); }
#pragma unroll
    for (int o = 1; o < 64; o <<= 1) {
#pragma unroll
        for (int r = 0; r < 4; ++r) s[r] += __shfl_xor(s[r], o); }
    f32x4 gg[4];
#pragma unroll
    for (int j = 0; j < 4; ++j) gg[j] = gr[64 * j];
#pragma unroll
    for (int r = 0; r < 4; ++r) { const float rs = rsqrtf(s[r] * (1.0f / D) + EPS); u32x2* o8 = (u32x2*)(orow + (size_t)r * D) + lane;
#pragma unroll
        for (int j = 0; j < 4; ++j) { u32x2 w; w.x = pk2(v[r][j][0] * rs * gg[j][0], v[r][j][1] * rs * gg[j][1]); w.y = pk2(v[r][j][2] * rs * gg[j][2], v[r][j][3] * rs * gg[j][3]); o8[64 * j] = w; } }
}

#define XB_TMO      128
#define XB_XCNT(j)  (256  + 64 * (j))
#define XB_XSUB(j)  (1280 + 64 * (j))
#define XB_XGEN(j)  (2304 + 64 * (j))
#define XB_TOP      3328
#define XB_TOPGEN   3392
#define XCD_BAR_WORDS 3456
#define XB_SPIN_CAP (1u << 20)
__device__ __forceinline__ unsigned xb_ld(unsigned* p)              { return __hip_atomic_load(p, __ATOMIC_RELAXED, __HIP_MEMORY_SCOPE_AGENT); }
__device__ __forceinline__ unsigned xb_add(unsigned* p, unsigned v) { return __hip_atomic_fetch_add(p, v, __ATOMIC_RELAXED, __HIP_MEMORY_SCOPE_AGENT); }
__device__ __forceinline__ unsigned xb_xcc_id() { return (unsigned)__builtin_amdgcn_s_getreg((3 << 11) | 20) & 0xFu; }
#define XB_SPIN(cond, bar) do { unsigned _sp = 0; while (cond) { __builtin_amdgcn_s_sleep(1); \
    if ((++_sp & 255u) == 0u) { if (xb_ld(&(bar)[XB_TMO])) break; if (_sp > XB_SPIN_CAP) { atomicAdd(&(bar)[XB_TMO], 1u); break; } } } } while (0)
struct XcdBarrier { unsigned* bar; unsigned x; volatile LAS unsigned* st; };
__device__ __forceinline__ XcdBarrier xcd_barrier_post(unsigned* bar, volatile LAS unsigned* st) {
    XcdBarrier b; b.bar = bar; b.x = xb_xcc_id(); b.st = st;
    if (threadIdx.x == 0) (void)xb_add(&bar[XB_XCNT(b.x)], 1u);
    return b;
}
__device__ __forceinline__ void xcd_barrier_complete(unsigned* bar, unsigned x, unsigned& nloc, unsigned& nx) {
    const unsigned G = gridDim.x * gridDim.y * gridDim.z;
    unsigned sum, cnt, mine, sp = 0u;
    for (;;) {
        sum = 0u; cnt = 0u; mine = 0u;
#pragma unroll
        for (unsigned j = 0; j < 16; ++j) { const unsigned c = xb_ld(&bar[XB_XCNT(j)]); sum += c; cnt += (c > 0u) ? 1u : 0u; mine = (j == x) ? c : mine; }
        if (sum == G) break;
        __builtin_amdgcn_s_sleep(1);
        if ((++sp & 255u) == 0u) { if (xb_ld(&bar[XB_TMO])) break; if (sp > XB_SPIN_CAP) { atomicAdd(&bar[XB_TMO], 1u); break; } }
    }
    nloc = mine > 0u ? mine : 1u; nx = cnt > 0u ? cnt : 1u;
}
__device__ __forceinline__ void xcd_barrier(const XcdBarrier& b) {
    asm volatile("s_waitcnt vmcnt(0)" ::: "memory");
    __syncthreads();
    if (threadIdx.x == 0) {
        unsigned* bar = b.bar;
        __builtin_amdgcn_s_waitcnt(0);
        unsigned nloc = b.st[0], nx = b.st[1];
        if (nloc == 0u) { xcd_barrier_complete(bar, b.x, nloc, nx); b.st[0] = nloc; b.st[1] = nx; }
        const unsigned old = xb_add(&bar[XB_XSUB(b.x)], 1u);
        const unsigned gen = old / nloc;
        if (old + 1u == (gen + 1u) * nloc) {
            __builtin_amdgcn_fence(__ATOMIC_RELEASE, "agent");
            asm volatile("s_waitcnt vmcnt(0)" ::: "memory");
            const unsigned og = xb_add(&bar[XB_TOP], 1u);
            const unsigned tg = og / nx;
            if (og + 1u == (tg + 1u) * nx) xb_add(&bar[XB_TOPGEN], 1u);
            else XB_SPIN(xb_ld(&bar[XB_TOPGEN]) == tg, bar);
            __builtin_amdgcn_fence(__ATOMIC_ACQUIRE, "agent");
            xb_add(&bar[XB_XGEN(b.x)], 1u);
            asm volatile("s_waitcnt vmcnt(0)" ::: "memory");
        } else {
            XB_SPIN(xb_ld(&bar[XB_XGEN(b.x)]) == gen, bar);
            __builtin_amdgcn_fence(__ATOMIC_ACQUIRE, "agent");
            asm volatile("s_waitcnt vmcnt(0)" ::: "memory");
        }
    }
    __syncthreads();
}

__global__ void __launch_bounds__(512, 2) fwd_kernel(Params p) {
    extern __shared__ __attribute__((aligned(16))) unsigned char lds_raw[];
    LAS unsigned char* lds = (LAS unsigned char*)lds_raw;
    const int tid = threadIdx.x, lane = tid & 63, wave = __builtin_amdgcn_readfirstlane(tid >> 6);
    const int G = gridDim.x, bid = blockIdx.x;
    unsigned char* ws = p.ws;
    bf16_t* WinT = (bf16_t*)(ws + WS_WIN); bf16_t* WkvT = (bf16_t*)(ws + WS_WKV); bf16_t* Wcat = (bf16_t*)(ws + WS_WCAT); bf16_t* WoutT = (bf16_t*)(ws + WS_WOUT);
    bf16_t* W1T = (bf16_t*)(ws + WS_W1); bf16_t* W2T = (bf16_t*)(ws + WS_W2);
    bf16_t* D1f = (bf16_t*)(ws + WS_TAB); bf16_t* D2f = D1f + 8192;
    bf16_t* memn = (bf16_t*)(ws + WS_MEMN); bf16_t* memkv = (bf16_t*)(ws + WS_MEMKV); float* ssq = (float*)(ws + WS_SSQ);
    unsigned char* gbuf = (unsigned char*)(ws + WS_G); bf16_t* zbuf = (bf16_t*)(ws + WS_Z); bf16_t* hbuf = (bf16_t*)(ws + WS_H);
    bf16_t* merged = (bf16_t*)(ws + WS_MERGED); bf16_t* xmb = (bf16_t*)(ws + WS_XMB); bf16_t* abuf = (bf16_t*)(ws + WS_A);
    bf16_t* pimg = hbuf;
    bf16_t* fuT = (bf16_t*)(ws + WS_FUT);
    bf16_t* act = (bf16_t*)p.out;

    const int lo = p.ph_lo, hi = p.ph_hi;
#ifdef ONLY_PHASE
#define IN(k) ((k) == ONLY_PHASE && lo <= (k) && (k) < hi)
#else
#define IN(k) (lo <= (k) && (k) < hi)
#endif
#define BOTH(k) (IN(k) && IN((k) + 1))
#define CG_SYNC() do { asm volatile("s_waitcnt vmcnt(0) lgkmcnt(0)" ::: "memory"); __syncthreads(); cg::this_grid().sync(); \
        if (threadIdx.x == 0) { __builtin_amdgcn_fence(__ATOMIC_ACQUIRE, "agent"); asm volatile("s_waitcnt vmcnt(0)" ::: "memory"); } __syncthreads(); } while (0)
#define GRID_SYNC() do { xcd_barrier(xbar); } while (0)
    volatile LAS unsigned* xst = (volatile LAS unsigned*)(lds + LDS_BYTES - 16);
    if (tid == 0) { xst[0] = 0u; xst[1] = 0u; }
    __syncthreads();
    XcdBarrier xbar = xcd_barrier_post((unsigned*)(ws + WS_BAR), xst);

    if (IN(0)) for (int rep_ = 0; rep_ < NREP(0); ++rep_) {
        if (rep_) GRID_SYNC();
        LAS float* scr = (LAS float*)(lds + wave * 16384);
        LAS float* ctab = (LAS float*)(lds + 131072);
        if (tid < 128) { ctab[tid] = cosrev((float)tid * (1.0f / 128.0f)); ctab[128 + tid] = sinrev((float)tid * (1.0f / 128.0f)); }
        __syncthreads();
        const int gw = bid * 8 + wave, NGW = G * 8;
        constexpr int I_IN = 16 * (NIN / 32), I_KV = 16 * 32;
        for (int it = gw; it < I_IN + I_KV; it += NGW) {
            if (it < I_IN) p0_transpose_item(p.w_in, NIN, WinT, D, 0, nullptr, scr, it, lane);
            else p0_transpose_item(p.w_mem_kv, D, WkvT, D, 0, nullptr, scr, it - I_IN, lane);
        }
        for (int m = gw * 4; m < M + MROWS; m += NGW * 4) {
            if (m < M) rms_rows4_to_bf16(p.x + (size_t)m * D, p.norm1_g, hbuf + (size_t)m * D, lane);
            else rms_rows4_to_bf16(p.mem + (size_t)(m - M) * D, p.mem_norm_g, memn + (size_t)(m - M) * D, lane);
        }
        for (int it = gw; it < 2048; it += NGW) {
            const int g = it >> 9, nb = (it >> 3) & 63, c0 = (it & 7) * 16, li = lane & 15, lk = lane >> 4, c = c0 + li;
            const float* wsrc = p.w_f + (size_t)(g * 128 + lk) * D + nb * 16 + li;
            f32x4 aC = (f32x4){0.f, 0.f, 0.f, 0.f}, aS = (f32x4){0.f, 0.f, 0.f, 0.f};
#pragma unroll 8
            for (int ks = 0; ks < 32; ++ks) { const float a = wsrc[(size_t)(4 * ks) * D]; const int idx = (c * (4 * ks + lk)) & 127;
                aC = __builtin_amdgcn_mfma_f32_16x16x4f32(a, ctab[idx], aC, 0, 0, 0); aS = __builtin_amdgcn_mfma_f32_16x16x4f32(a, ctab[128 + idx], aS, 0, 0, 0); }
            const float sc = 0.08838834764831845f;
            bf16_t* dst = Wcat + (size_t)(nb * 16 + 4 * lk) * 2048 + 512 + (g * 32 + (c >> 2)) * 8 + 2 * (c & 3);
#pragma unroll
            for (int e = 0; e < 4; ++e) *(unsigned*)(dst + (size_t)e * 2048) = pk2(aC[e] * sc, aS[e] * sc);
        }
        for (int e = bid * 512 + tid; e < 8192 + 16384; e += G * 512) {
            if (e < 8192) { const int j = e & 7, ln = (e >> 3) & 63, ks = (e >> 9) & 1, mb = e >> 10; const int r = ln & 15, gq = ln >> 4;
                const int kb = 16 * (mb >> 1) + r, part = mb & 1, sb = ks * 32 + 8 * gq + j; const float rev = (float)((kb * sb) & 63) * (1.0f / 64.0f);
                D1f[e] = (bf16_t)f2bf(part ? -sinrev(rev) : cosrev(rev)); }
            else { const int e2 = e - 8192; const int j = e2 & 7, ln = (e2 >> 3) & 63, ks = (e2 >> 9) & 3, mb = e2 >> 11; const int r = ln & 15, gq = ln >> 4;
                const int o = r & 1, ka = 8 * mb + (r >> 1), k = ks * 32 + 8 * gq + j, sa = k >> 1, i = k & 1; const float rev = (float)((ka * sa) & 63) * (1.0f / 64.0f);
                const float cv = cosrev(rev), sv = sinrev(rev); const float val = (o == 0) ? (i == 0 ? cv : sv) : (i == 0 ? -sv : cv);
                D2f[e2] = (bf16_t)f2bf(val); }
        }
        __syncthreads();
    }
    if (BOTH(0)) GRID_SYNC();
    if (p.ph_lo == 0x7fffffff) CG_SYNC();

    if (IN(1)) for (int rep_ = 0; rep_ < NREP(1); ++rep_) {
        if (rep_) GRID_SYNC();
        pg8::Gemm g{hbuf, WinT, memn, WkvT, D, D, D, nullptr, 128, 128};
        pg8::ComboOrder S; S.s.init(M, NIN, G, bid); S.extra = (MROWS / 256) * (D / 256); S.extra_nn = D / 256; S.rot = 10;
        pg8::EpiInProj E{zbuf, gbuf, memkv, p.b_gate, p.na_q_g, p.na_k_g, (LAS float*)(lds + 131072), fuT};
        pg8::gemm_phase<pg8::EpiInProj, pg8::ComboOrder, true>(lds, g, S, E);
        {
            constexpr int NTILES = (M / 256) * (NIN / 256) + (MROWS / 256) * (D / 256);
            const int nfull = NTILES % G;
            int nw = G - nfull, first = nfull; if (nfull == 0 || nw < 32) { nw = G; first = 0; }
            if (bid >= first) {
                LAS float* scr = (LAS float*)(lds + wave * 16384);
                if (bid == G - 1 && wave == 0) {
                    float mg = fabsf(p.na_q_g[lane] * p.na_k_g[lane]), mb_ = 0.f;
                    for (int e = lane; e < 8 * 465; e += 64) mb_ = fmaxf(mb_, fabsf(p.na_rpb[e]));
#pragma unroll
                    for (int o = 1; o < 64; o <<= 1) { mg = fmaxf(mg, __shfl_xor(mg, o)); mb_ = fmaxf(mb_, __shfl_xor(mb_, o)); }
                    if (lane == 0) *(float*)(ws + WS_NSHIFT) = 8.0f * mg + mb_;
                }
                const int gw = (bid - first) * 8 + wave, NGW = nw * 8;
                constexpr int I_NAO = 8 * 32, I_MO = 8 * 32, I_OUT = 16 * 32, I_1 = 16 * (FF / 32), I_2 = 64 * 32;
                constexpr int NT_ITEMS = I_NAO + I_MO + I_OUT + I_1 + I_2;
                for (int it = gw; it < NT_ITEMS; it += NGW) {
                    int r = it;
                    if (r < I_NAO) { p0_transpose_item(p.w_na_o, D, Wcat, 2048, 0, nullptr, scr, r, lane); continue; } r -= I_NAO;
                    if (r < I_MO) { p0_transpose_item(p.w_mem_o, D, Wcat, 2048, 1536, nullptr, scr, r, lane); continue; } r -= I_MO;
                    if (r < I_OUT) { p0_transpose_item(p.w_out, D, WoutT, D, 0, nullptr, scr, r, lane); continue; } r -= I_OUT;
                    if (r < I_1) { p0_transpose_item(p.w_ff1, FF, W1T, D, 0, p.norm2_g, scr, r, lane); continue; } r -= I_1;
                    p0_transpose_item(p.w_ff2, D, W2T, FF, 0, nullptr, scr, r, lane, (size_t)D * 64);
                }

                __syncthreads();
            }
        }
    }
    if (BOTH(1)) GRID_SYNC();

    if (IN(2)) for (int rep_ = 0; rep_ < NREP(2); ++rep_) {
        if (rep_) GRID_SYNC();
        const int vb = (G % 8 == 0) ? (bid & 7) * (G >> 3) + (bid >> 3) : bid;
        const bool al = (G == 256); const int xq = bid & 7, jq = bid >> 3;
#ifndef NO_NA
        for (int rm_ = 0; rm_ < ((DUP_MIX == 0) ? 2 : 1); ++rm_) {
            int lane_o = lane, tid_o = tid; asm volatile("" : "+v"(lane_o), "+v"(tid_o)); const int q16 = lane_o & 15, g4 = lane_o >> 4;
            const int hs = wave >> 2, rsel = (wave >> 1) & 1, qp = wave & 1;
            LAS float* sbias = (LAS float*)(lds + 65536);
            LAS float* bpad = (LAS float*)(lds + 69632);
            for (int e = tid_o; e < 465; e += 512) bpad[e] = -1e30f;
            int hq_prev = -1;
            int boff[2][2][4];
#pragma unroll
            for (int qbi = 0; qbi < 2; ++qbi) { const int qb = 2 * qp + qbi; const int kstart = (qb == 0) ? 0 : (qb == 1) ? 8 : (qb == 2) ? 24 : 32; const int c = 16 * qb + q16, cs = min(max(c - 8, 0), 48);
#pragma unroll
                for (int kb = 0; kb < 2; ++kb)
#pragma unroll
                    for (int e = 0; e < 4; ++e) { const int kc = kstart + 16 * kb + 4 * g4 + e; const bool valid = (kc >= cs) && (kc < cs + 16);
                        boff[qbi][kb][e] = valid ? (65536 + (hs * 465 + (kc - c + 15)) * 4) : 69632; } }
            for (int un = vb, kq = 0; un < BATCH * 32 * 4; un += G, ++kq) {
                int b = un >> 7, rp = (un >> 2) & 31, hq = un & 3;
                if (al) { const int lu = kq * 32 + jq; b = xq >> 1; rp = 16 * (xq & 1) + (lu >> 2); hq = lu & 3; }
                const int h = hq * 2 + hs, r = 2 * rp + rsel;
                const int rs_r = min(max(r - 4, 0), 56), kr_lo = min(max(2 * rp - 4, 0), 56), nrows = min(max(2 * rp + 1 - 4, 0), 56) + 8 - kr_lo;
                const size_t tok0 = (size_t)b * SEQ;
                __syncthreads();
                if (hq != hq_prev) { const float nshift = *(const float*)(ws + WS_NSHIFT);
                    for (int e = tid_o; e < 2 * 465; e += 512) sbias[e] = (p.na_rpb[hq * 2 * 465 + e] - nshift) * 1.4426950408889634f; hq_prev = hq; }
                u32x4 kreg[2][2], vreg[2][2];
#define NA_LOAD_ROW(kr_, st_) do { const size_t kt_ = tok0 + (size_t)(kr_) * 64; _Pragma("unroll") for (int i = 0; i < 2; ++i) { const int cid = i * 512 + tid_o, key = (cid >> 3) & 63, ch = cid & 7, hsl = cid >> 9; \
                        const bf16_t* sp_ = zbuf + (kt_ + key) * NZ + (hq * 2 + hsl) * 64 + ch * 8; kreg[st_][i] = *(const u32x4*)(sp_ + OFF_K); vreg[st_][i] = *(const u32x4*)(sp_ + OFF_V); } } while (0)
#define NA_WRITE_ROW(buf_, st_) do { _Pragma("unroll") for (int i = 0; i < 2; ++i) { const int cid = i * 512 + tid_o, key = (cid >> 3) & 63, ch = cid & 7, hsl = cid >> 9; \
                        LAS unsigned char* kb_ = lds + (buf_) * 32768 + hsl * 16384 + key * 128 + ((ch ^ (key & 7)) * 16); \
                        *(LAS u32x4*)kb_ = kreg[st_][i]; *(LAS u32x4*)(kb_ + 8192) = vreg[st_][i]; } } while (0)
                NA_LOAD_ROW(kr_lo, 0); NA_LOAD_ROW(kr_lo + 1, 1);
                bf16x8 qf[2][2];
#pragma unroll
                for (int qbi = 0; qbi < 2; ++qbi) {
                    const int qb = 2 * qp + qbi;
                    const bf16_t* src = zbuf + (tok0 + r * 64 + 16 * qb + q16) * NZ + OFF_Q + h * 64;
                    qf[qbi][0] = *(const bf16x8*)(src + 8 * g4); qf[qbi][1] = *(const bf16x8*)(src + 32 + 8 * g4);
                }
                NA_WRITE_ROW(0, 0);
                float lrun[2]; f32x4 O[2][4];
#pragma unroll
                for (int qbi = 0; qbi < 2; ++qbi) { lrun[qbi] = 0.f;
#pragma unroll
                    for (int db = 0; db < 4; ++db) O[qbi][db] = (f32x4){0.f, 0.f, 0.f, 0.f}; }
                asm volatile("s_waitcnt lgkmcnt(0)" ::: "memory"); __builtin_amdgcn_s_barrier(); asm volatile("" ::: "memory");
#define NA_ROW(i_, cur_) do { const int kr = kr_lo + (i_); \
                    if ((i_) + 2 < nrows) NA_LOAD_ROW(kr + 2, cur_); \
                    if (kr >= rs_r && kr < rs_r + 8) {            \
                        const LAS unsigned char* Kb = lds + (cur_) * 32768 + hs * 16384; const LAS unsigned char* Vb = Kb + 8192; \
                        const int dr124 = (kr - r + 7) * 124; \
                        _Pragma("unroll") for (int qbi = 0; qbi < 2; ++qbi) { \
                            const int qb = 2 * qp + qbi; const int kstart = (qb == 0) ? 0 : (qb == 1) ? 8 : (qb == 2) ? 24 : 32; \
                            float pe[2][4]; float ps = 0.f; \
                            _Pragma("unroll") for (int kb = 0; kb < 2; ++kb) { \
                                const int key = kstart + 16 * kb + q16, sw = key & 7; \
                                const bf16x8 k0 = *(const LAS bf16x8*)(Kb + key * 128 + ((g4 ^ sw) * 16)), k1 = *(const LAS bf16x8*)(Kb + key * 128 + (((4 + g4) ^ sw) * 16)); \
                                f32x4 sa = (f32x4){0.f, 0.f, 0.f, 0.f}; \
                                sa = MFMA16(k0, qf[qbi][0], sa); sa = MFMA16(k1, qf[qbi][1], sa); \
                                _Pragma("unroll") for (int e = 0; e < 4; ++e) { const float bv = *(const LAS float*)(lds + boff[qbi][kb][e] + dr124); pe[kb][e] = __builtin_amdgcn_exp2f(sa[e] + bv); ps += pe[kb][e]; } \
                            } \
                            lrun[qbi] += ps; \
                            u32x4 pw; pw.x = cvt_pk_bf16(pe[0][0], pe[0][1]); pw.y = cvt_pk_bf16(pe[0][2], pe[0][3]); pw.z = cvt_pk_bf16(pe[1][0], pe[1][1]); pw.w = cvt_pk_bf16(pe[1][2], pe[1][3]); \
                            const bf16x8 pf = __builtin_bit_cast(bf16x8, pw); \
                            const int qq = q16 >> 2, pp = q16 & 3; \
                            const int rlo = kstart + 4 * g4 + qq, rhi = rlo + 16; \
                            _Pragma("unroll") for (int db = 0; db < 4; ++db) { \
                                const int chv = db * 2 + (pp >> 1), sub = (pp & 1) * 8; \
                                const s16x4 lo4 = __builtin_amdgcn_ds_read_tr16_b64_v4i16((LAS s16x4*)(Vb + rlo * 128 + ((chv ^ (rlo & 7)) * 16) + sub)); \
                                const s16x4 hi4 = __builtin_amdgcn_ds_read_tr16_b64_v4i16((LAS s16x4*)(Vb + rhi * 128 + ((chv ^ (rhi & 7)) * 16) + sub)); \
                                const bf16x8 vf = __builtin_shufflevector(lo4, hi4, 0, 1, 2, 3, 4, 5, 6, 7); \
                                O[qbi][db] = MFMA16(vf, pf, O[qbi][db]); \
                            } \
                        } \
                    } \
                    if ((i_) + 1 < nrows) NA_WRITE_ROW((cur_) ^ 1, (cur_) ^ 1); \
                    asm volatile("s_waitcnt lgkmcnt(0)" ::: "memory"); __builtin_amdgcn_s_barrier(); asm volatile("" ::: "memory"); } while (0)
#pragma unroll 1
                for (int i2 = 0; i2 < 10; i2 += 2) {
                    if (i2 < nrows) NA_ROW(i2, 0);
                    if (i2 + 1 < nrows) NA_ROW(i2 + 1, 1);
                }
#undef NA_ROW
#undef NA_LOAD_ROW
#undef NA_WRITE_ROW
#pragma unroll
                for (int qbi = 0; qbi < 2; ++qbi) { const int qb = 2 * qp + qbi; float lt = lrun[qbi]; lt += __shfl_xor(lt, 16); lt += __shfl_xor(lt, 32); const float il = 1.0f / lt;
                    bf16_t* dst = act + (tok0 + r * 64 + 16 * qb + q16) * ACT_LD + h * 64 + ((g4 & 1) ? 16 + 4 * (g4 - 1) : 4 * g4);
#pragma unroll
                    for (int dp = 0; dp < 2; ++dp) { const f32x4 oa = O[qbi][2 * dp] * il, ob = O[qbi][2 * dp + 1] * il;
                        const auto rx = __builtin_amdgcn_permlane16_swap(cvt_pk_bf16(oa[0], oa[1]), cvt_pk_bf16(ob[0], ob[1]), false, false);
                        const auto ry = __builtin_amdgcn_permlane16_swap(cvt_pk_bf16(oa[2], oa[3]), cvt_pk_bf16(ob[2], ob[3]), false, false);
                        u32x4 w; w.x = rx[0]; w.y = ry[0]; w.z = rx[1]; w.w = ry[1];
                        *(u32x4*)(dst + dp * 32) = w; } }
            }
            __syncthreads();
        }
#endif
#ifndef NO_FFT
        for (int rm_ = 0; rm_ < ((DUP_MIX == 1) ? 2 : 1); ++rm_) {
            int lane_o = lane, tid_o = tid; asm volatile("" : "+v"(lane_o), "+v"(tid_o)); const int q16 = lane_o & 15, g4 = lane_o >> 4;
            constexpr int ZP = 272;
            LAS unsigned char* Zt = lds;
            LAS unsigned char* XI = lds + 69632;
            u32x4 xin[4];
#define FFT_UNIT(kq_, b_, cb_) do { b_ = (vb + (kq_) * G) >> 7; cb_ = (vb + (kq_) * G) & 127; if (al) { b_ = xq >> 1; cb_ = 64 * (xq & 1) + (kq_) * 32 + jq; } } while (0)
#define FFT_FETCH(b_, cb_) do { const bf16_t* sp_ = fuT + (size_t)((b_) * 128 + (cb_)) * 4096 * 4; _Pragma("unroll") for (int i = 0; i < 4; ++i) xin[i] = *(const u32x4*)(sp_ + (size_t)(i * 512 + tid_o) * 8); } while (0)
            { int b0_, cb0_; FFT_UNIT(0, b0_, cb0_); if (vb < BATCH * 128) FFT_FETCH(b0_, cb0_); }
            for (int un = vb, kq = 0; un < BATCH * 128; un += G, ++kq) {
                int b, cb; FFT_UNIT(kq, b, cb);
                asm volatile("s_waitcnt lgkmcnt(0)" ::: "memory"); __builtin_amdgcn_s_barrier(); asm volatile("" ::: "memory");
#pragma unroll
                for (int i = 0; i < 4; ++i) *(LAS u32x4*)(XI + (i * 512 + tid_o) * 16) = xin[i];
                asm volatile("s_waitcnt lgkmcnt(0)" ::: "memory"); __builtin_amdgcn_s_barrier(); asm volatile("" ::: "memory");
#pragma unroll 1
                for (int ngi = 0; ngi < 2; ++ngi) {
                    const int ng = 2 * wave + ngi, sa = 4 * ng + (q16 >> 2), c = q16 & 3;
                    const LAS unsigned char* xp = XI + (sa + 512 * g4) * 8 + c * 2;
                    bf16x8 bfr[2];
#pragma unroll
                    for (int ks = 0; ks < 2; ++ks)
#pragma unroll
                        for (int j = 0; j < 8; ++j) bfr[ks][j] = *(const LAS short*)(xp + (64 * (ks * 32 + j)) * 8);
                    f32x4 acc[8];
#pragma unroll
                    for (int mb = 0; mb < 8; ++mb) { acc[mb] = (f32x4){0.f, 0.f, 0.f, 0.f};
#pragma unroll
                        for (int ks = 0; ks < 2; ++ks) { const bf16x8 af = *(const bf16x8*)(D1f + ((mb * 2 + ks) * 64 + lane_o) * 8); acc[mb] = MFMA16(af, bfr[ks], acc[mb]); } }
#pragma unroll
                    for (int t = 0; t < 4; ++t)
#pragma unroll
                        for (int e = 0; e < 4; ++e) { const int kb = 16 * t + 4 * g4 + e; const float rev = (float)(kb * sa) * (1.0f / 4096.0f);
                            const float ct = cosrev(rev), st = sinrev(rev), zr = acc[2 * t][e], zi = acc[2 * t + 1][e];
                            *(LAS unsigned*)(Zt + (kb * 4 + c) * ZP + sa * 4) = cvt_pk_bf16(zr * ct + zi * st, zi * ct - zr * st); }
                }
                if (un + G < BATCH * 128) { int b2_, cb2_; FFT_UNIT(kq + 1, b2_, cb2_); FFT_FETCH(b2_, cb2_); }
                asm volatile("s_waitcnt lgkmcnt(0)" ::: "memory"); __builtin_amdgcn_s_barrier(); asm volatile("" ::: "memory");
                {
                    const int mb = wave; bf16x8 af[4];
#pragma unroll
                    for (int ks = 0; ks < 4; ++ks) af[ks] = *(const bf16x8*)(D2f + ((mb * 4 + ks) * 64 + lane_o) * 8);
                    LAS unsigned char* OUTI = lds + 69632;
#pragma unroll 4
                    for (int nb = 0; nb < 16; ++nb) {
                        f32x4 a2 = (f32x4){0.f, 0.f, 0.f, 0.f};
#pragma unroll
                        for (int ks = 0; ks < 4; ++ks) { const bf16x8 bfg = *(const LAS bf16x8*)(Zt + (nb * 16 + q16) * ZP + ks * 64 + g4 * 16); a2 = MFMA16(af[ks], bfg, a2); }
                        const int kb = 4 * nb + (q16 >> 2), c = q16 & 3, ka0 = 8 * mb + 2 * g4;
                        *(LAS unsigned*)(OUTI + (64 * ka0 + kb) * 16 + c * 4) = cvt_pk_bf16(a2[0] * (1.0f / 64.0f), a2[1] * (1.0f / 64.0f));
                        *(LAS unsigned*)(OUTI + (64 * (ka0 + 1) + kb) * 16 + c * 4) = cvt_pk_bf16(a2[2] * (1.0f / 64.0f), a2[3] * (1.0f / 64.0f));
                    }
                    asm volatile("s_waitcnt lgkmcnt(0)" ::: "memory"); __builtin_amdgcn_s_barrier(); asm volatile("" ::: "memory");
                    bf16_t* dstp = pimg + ((size_t)(b * 128 + cb) * 4096) * 8;
#pragma unroll
                    for (int i = 0; i < 8; ++i) { const int id = i * 512 + tid_o; *(u32x4*)(dstp + (size_t)id * 8) = *(const LAS u32x4*)(OUTI + id * 16); }
                }
            }
            __syncthreads();
        }
#undef FFT_UNIT
#undef FFT_FETCH
#endif
#ifndef NO_CROSS
        for (int rm_ = 0; rm_ < ((DUP_MIX == 2) ? 2 : 1); ++rm_) {
            int lane_o = lane, tid_o = tid; asm volatile("" : "+v"(lane_o), "+v"(tid_o)); const int q16 = lane_o & 15, g4 = lane_o >> 4;
            constexpr int KP = 272;
            LAS unsigned char* Ks = lds; LAS unsigned char* Vm = lds + 69632; LAS float* rsk = (LAS float*)(lds + 139264);
            for (int un = vb; un < BATCH * 4 * 16; un += G) {
                int b = un >> 6, hm = (un >> 4) & 3, qt = un & 15;
                if (al) { const int pmq = 8 * xq + (jq >> 2); b = pmq >> 4; qt = pmq & 15; hm = jq & 3; }
                __syncthreads();
#pragma unroll
                for (int i = 0; i < 8; ++i) { const int id = i * 512 + tid_o, row = id >> 4, ch = id & 15;

#ifdef EXP_KV_FROM_MEMN
                    const bf16_t* src = memn + ((size_t)b * MEMT + row) * D + hm * 128 + ch * 8;
#else
                    const bf16_t* src = memkv + ((size_t)b * MEMT + row) * D + hm * 128 + ch * 8;
#endif

                    const u32x4 kv = *(const u32x4*)src; const u32x4 vv = *(const u32x4*)(src + 512);
                    float s = 0.f, t;
                    t = bf_lo(kv.x); s += t * t; t = bf_hi(kv.x); s += t * t; t = bf_lo(kv.y); s += t * t; t = bf_hi(kv.y); s += t * t;
                    t = bf_lo(kv.z); s += t * t; t = bf_hi(kv.z); s += t * t; t = bf_lo(kv.w); s += t * t; t = bf_hi(kv.w); s += t * t;
                    s += __shfl_xor(s, 1); s += __shfl_xor(s, 2); s += __shfl_xor(s, 4); s += __shfl_xor(s, 8);
                    if (ch == 0) rsk[row] = rsqrtf(s * (1.0f / 128.0f) + EPS);
                    *(LAS u32x4*)(Ks + row * KP + ch * 16) = kv; *(LAS u32x4*)(Vm + row * KP + ch * 16) = vv; }
                __syncthreads();
#pragma unroll 1
                for (int qbi = 0; qbi < 2; ++qbi) {
                    const size_t tok = (size_t)b * SEQ + qt * 256 + wave * 32 + qbi * 16 + q16;
                    const bf16_t* src = zbuf + tok * NZ + OFF_MQ + hm * 128;
                    bf16x8 qf[4];
                    { u32x4 raw[4]; float s = 0.f;
#pragma unroll
                      for (int ks = 0; ks < 4; ++ks) { raw[ks] = *(const u32x4*)(src + ks * 32 + 8 * g4); float t;
                          t = bf_lo(raw[ks].x); s += t * t; t = bf_hi(raw[ks].x); s += t * t; t = bf_lo(raw[ks].y); s += t * t; t = bf_hi(raw[ks].y); s += t * t;
                          t = bf_lo(raw[ks].z); s += t * t; t = bf_hi(raw[ks].z); s += t * t; t = bf_lo(raw[ks].w); s += t * t; t = bf_hi(raw[ks].w); s += t * t; }
                      s += __shfl_xor(s, 16); s += __shfl_xor(s, 32);
                      const float rq = rsqrtf(s * (1.0f / 128.0f) + EPS) * 0.08838834764831845f;
#pragma unroll
                      for (int ks = 0; ks < 4; ++ks) { const int d0 = ks * 32 + 8 * g4; float gg[8];
#pragma unroll
                          for (int j = 0; j < 8; ++j) gg[j] = p.mem_q_g[d0 + j] * p.mem_k_g[d0 + j] * rq;
                          u32x4 w; w.x = cvt_pk_bf16(bf_lo(raw[ks].x) * gg[0], bf_hi(raw[ks].x) * gg[1]); w.y = cvt_pk_bf16(bf_lo(raw[ks].y) * gg[2], bf_hi(raw[ks].y) * gg[3]);
                          w.z = cvt_pk_bf16(bf_lo(raw[ks].z) * gg[4], bf_hi(raw[ks].z) * gg[5]); w.w = cvt_pk_bf16(bf_lo(raw[ks].w) * gg[6], bf_hi(raw[ks].w) * gg[7]);
                          qf[ks] = __builtin_bit_cast(bf16x8, w); } }
                    f32x4 S[16];
#pragma unroll
                    for (int kb = 0; kb < 16; ++kb) { S[kb] = (f32x4){0.f, 0.f, 0.f, 0.f};
#pragma unroll
                        for (int ks = 0; ks < 4; ++ks) { const bf16x8 kf = *(const LAS bf16x8*)(Ks + (kb * 16 + q16) * KP + ks * 64 + g4 * 16); S[kb] = MFMA16(kf, qf[ks], S[kb]); }
                        const f32x4 rk4 = *(const LAS f32x4*)(rsk + kb * 16 + 4 * g4); S[kb] *= rk4; __builtin_amdgcn_sched_barrier(0); }
                    float mx = -1e30f;
#pragma unroll
                    for (int kb = 0; kb < 16; ++kb) mx = fmaxf(mx, fmaxf(fmaxf(S[kb][0], S[kb][1]), fmaxf(S[kb][2], S[kb][3])));
                    mx = fmaxf(mx, __shfl_xor(mx, 16)); mx = fmaxf(mx, __shfl_xor(mx, 32));
                    float ps = 0.f;
#pragma unroll
                    for (int kb = 0; kb < 16; ++kb)
#pragma unroll
                        for (int e = 0; e < 4; ++e) { S[kb][e] = __expf(S[kb][e] - mx); ps += S[kb][e]; }
                    ps += __shfl_xor(ps, 16); ps += __shfl_xor(ps, 32);
                    const float il = 1.0f / ps;
                    f32x4 Oa[8];
#pragma unroll
                    for (int db = 0; db < 8; ++db) Oa[db] = (f32x4){0.f, 0.f, 0.f, 0.f};
#pragma unroll
                    for (int kp = 0; kp < 8; ++kp) {
                        u32x4 pw; pw.x = cvt_pk_bf16(S[2 * kp][0], S[2 * kp][1]); pw.y = cvt_pk_bf16(S[2 * kp][2], S[2 * kp][3]); pw.z = cvt_pk_bf16(S[2 * kp + 1][0], S[2 * kp + 1][1]); pw.w = cvt_pk_bf16(S[2 * kp + 1][2], S[2 * kp + 1][3]);
                        const bf16x8 pf = __builtin_bit_cast(bf16x8, pw);
#pragma unroll
                        for (int db = 0; db < 8; ++db) {
                            bf16x8 vf;
#if USE_TR
                            { const int qq = q16 >> 2, pp = q16 & 3;
                              const s16x4 lo4 = __builtin_amdgcn_ds_read_tr16_b64_v4i16((LAS s16x4*)(Vm + (32 * kp + 4 * g4 + qq) * KP + (db * 16 + 4 * pp) * 2));
                              const s16x4 hi4 = __builtin_amdgcn_ds_read_tr16_b64_v4i16((LAS s16x4*)(Vm + (32 * kp + 16 + 4 * g4 + qq) * KP + (db * 16 + 4 * pp) * 2));
                              vf = __builtin_shufflevector(lo4, hi4, 0, 1, 2, 3, 4, 5, 6, 7); }
#else
#pragma unroll
                            for (int j = 0; j < 8; ++j) { const int key = 32 * kp + ((j < 4) ? 0 : 16) + 4 * g4 + (j & 3); vf[j] = *(LAS short*)(Vm + key * KP + (db * 16 + q16) * 2); }
#endif
                            Oa[db] = MFMA16(vf, pf, Oa[db]);
                        }
                        __builtin_amdgcn_sched_barrier(0);
                    }
                    { const rsrc_t ars = mk_rsrc(act);
                      const unsigned o0 = (unsigned)((tok * ACT_LD + 1536 + hm * 128 + ((g4 & 1) ? 16 + 4 * (g4 - 1) : 4 * g4)) * 2);
#pragma unroll
                      for (int dp = 0; dp < 4; ++dp) { const f32x4 oa = Oa[2 * dp] * il, ob = Oa[2 * dp + 1] * il;
                          const auto rx = __builtin_amdgcn_permlane16_swap(cvt_pk_bf16(oa[0], oa[1]), cvt_pk_bf16(ob[0], ob[1]), false, false);
                          const auto ry = __builtin_amdgcn_permlane16_swap(cvt_pk_bf16(oa[2], oa[3]), cvt_pk_bf16(ob[2], ob[3]), false, false);
                          u32x4 w; w.x = rx[0]; w.y = ry[0]; w.z = rx[1]; w.w = ry[1];
                          st16_wt(ars, o0 + dp * 64, w); } }
                }
            }
            __syncthreads();
        }
#endif
    }
    if (BOTH(2)) GRID_SYNC();

    if (IN(3)) for (int rep_ = 0; rep_ < NREP(3); ++rep_) {
        if (rep_) GRID_SYNC();
#ifdef EXP_BRANCH
        constexpr int eoff = (EXP_BRANCH == 0) ? 0 : (EXP_BRANCH == 1) ? 512 : 1536, ek = (EXP_BRANCH == 1) ? 1024 : 512;
        pg8::Gemm g{act + eoff, Wcat + eoff, act, Wcat, ACT_LD, 2048, ek, nullptr, 128, 128};
#else
        pg8::Gemm g{act, Wcat, act, Wcat, ACT_LD, 2048, 2048, pimg, 128, 128};
#endif
        pg8::StaticOrder S; S.init(M, D, G, bid);
        pg8::EpiMerge E{gbuf, merged};
        pg8::gemm_phase<pg8::EpiMerge, pg8::StaticOrder, false, true>(lds, g, S, E);
    }
    if (BOTH(3)) GRID_SYNC();

    if (IN(4)) for (int rep_ = 0; rep_ < NREP(4); ++rep_) {
        if (rep_) GRID_SYNC();
        pg8::Gemm g{merged, WoutT, merged, WoutT, D, D, D, nullptr, 128, 128};
        pg8::StaticOrder S; S.init(M, D, G, bid);
        pg8::EpiWout E{p.x, xmb, ssq, (LAS float*)(lds + 131072)};
        pg8::gemm_phase<pg8::EpiWout, pg8::StaticOrder, true>(lds, g, S, E);
    }
    if (BOTH(4)) GRID_SYNC();

    if (IN(5)) for (int rep_ = 0; rep_ < NREP(5); ++rep_) {
        if (rep_) GRID_SYNC();
        pg8::Gemm g{xmb, W1T, xmb, W1T, D, D, D, nullptr, 128, 128};
        pg8::StaticOrder S; S.init(M, FF, G, bid);
        { volatile LAS int* cpm = (volatile LAS int*)(lds + 131072 + 1024); if (tid == 0) *cpm = -1; __syncthreads(); }
        pg8::EpiFfn1 E{ssq, abuf, (LAS float*)(lds + 131072)};
        pg8::gemm_phase<pg8::EpiFfn1, pg8::StaticOrder, true>(lds, g, S, E);
    }
    if (BOTH(5)) GRID_SYNC();

    if (IN(6)) for (int rep_ = 0; rep_ < NREP(6); ++rep_) {
        if (rep_) GRID_SYNC();
        pg8::Gemm g{abuf, W2T, abuf, W2T, 64, 64, FF, nullptr, (size_t)M * 128, (size_t)D * 128};
        pg8::StaticOrder S; S.init(M, D, G, bid);
        pg8::EpiFfn2 E{xmb, p.out};
        pg8::gemm_phase<pg8::EpiFfn2, pg8::StaticOrder, false>(lds, g, S, E);
    }
#undef IN
#undef BOTH
}

extern "C" void kernel_launch(void* const* d_in, const int* in_sizes, int n_in, void* d_out, int out_size, void* d_ws, size_t ws_size, hipStream_t stream) {
    static int grid = 0;
    if (grid == 0) {
        if (n_in != 19 || out_size != M * D || ws_size < WS_END) { fprintf(stderr, "kernel_launch: unexpected shapes (n_in %d out %d ws %zu)\n", n_in, out_size, ws_size); grid = -1; return; }
        int dev = 0, cus = 0, per_cu = 0;
        hipGetDevice(&dev); hipDeviceGetAttribute(&cus, hipDeviceAttributeMultiprocessorCount, dev);
        hipFuncSetAttribute((const void*)fwd_kernel, hipFuncAttributeMaxDynamicSharedMemorySize, LDS_BYTES);
        hipOccupancyMaxActiveBlocksPerMultiprocessor(&per_cu, (const void*)fwd_kernel, 512, LDS_BYTES);
        if (per_cu < 1) { fprintf(stderr, "kernel_launch: occupancy query says %d blocks/CU\n", per_cu); per_cu = 1; }
        (void)hipGetLastError();
        grid = cus * per_cu;
    }
    if (grid < 0) return;
    Params p{};
    p.x = (const float*)d_in[0]; p.mem = (const float*)d_in[1]; p.norm1_g = (const float*)d_in[2]; p.w_in = (const float*)d_in[3]; p.b_gate = (const float*)d_in[4];
    p.na_q_g = (const float*)d_in[5]; p.na_k_g = (const float*)d_in[6]; p.na_rpb = (const float*)d_in[7]; p.w_na_o = (const float*)d_in[8]; p.w_f = (const float*)d_in[9];
    p.mem_norm_g = (const float*)d_in[10]; p.w_mem_kv = (const float*)d_in[11]; p.mem_q_g = (const float*)d_in[12]; p.mem_k_g = (const float*)d_in[13]; p.w_mem_o = (const float*)d_in[14];
    p.w_out = (const float*)d_in[15]; p.norm2_g = (const float*)d_in[16]; p.w_ff1 = (const float*)d_in[17]; p.w_ff2 = (const float*)d_in[18];
    p.out = (float*)d_out; p.ws = (unsigned char*)d_ws;
#if MK_N_LAUNCHES == 1
    (void)hipMemsetAsync((char*)d_ws + WS_BAR, 0, XCD_BAR_WORDS * 4, stream);
    p.ph_lo = 0; p.ph_hi = 7;
    void* args[] = {&p};
    hipError_t e = hipLaunchCooperativeKernel((const void*)fwd_kernel, dim3(grid), dim3(512), args, LDS_BYTES, stream);
    if (e != hipSuccess) fprintf(stderr, "cooperative launch failed: %s (grid %d)\n", hipGetErrorString(e), grid);
#else
    for (int ph = 0; ph < 7; ++ph) { p.ph_lo = ph; p.ph_hi = ph + 1; hipLaunchKernelGGL(fwd_kernel, dim3(grid), dim3(512), LDS_BYTES, stream, p); }
#endif
}
```

```cpp
#include <hip/hip_runtime.h>
#include <hip/hip_cooperative_groups.h>
#include <cstdio>
#include <cstdint>
namespace cg = cooperative_groups;

#ifndef MK_N_LAUNCHES
#define MK_N_LAUNCHES 1
#endif
#ifndef DUP_PHASE
#define DUP_PHASE -1
#endif
#define NREP(k) (((k) == DUP_PHASE) ? 2 : 1)
#define DUP_MIX -1
#ifndef USE_TR
#define USE_TR 1
#endif

#define LAS __attribute__((address_space(3)))
typedef unsigned short bf16_t;
typedef short bf16x8 __attribute__((ext_vector_type(8)));
typedef short s16x4 __attribute__((ext_vector_type(4)));
typedef float f32x4 __attribute__((ext_vector_type(4)));
typedef unsigned u32x4 __attribute__((ext_vector_type(4)));
typedef unsigned u32x2 __attribute__((ext_vector_type(2)));

constexpr int D = 1024, BATCH = 4, SEQ = 4096, M = BATCH * SEQ, NIN = 5632, NZ = 2560, NG = 3072, FF = 4096, MEMT = 256, MROWS = BATCH * MEMT;
constexpr int OFF_Q = 0, OFF_K = 512, OFF_V = 1024, OFF_F = 1536, OFF_MQ = 2048;
constexpr int ACT_LD = 2048;
constexpr float EPS = 1e-6f;
constexpr size_t MiB = 1u << 20;
constexpr size_t WS_WIN = 0, WS_WKV = 11 * MiB, WS_WCAT = 13 * MiB, WS_WOUT = 17 * MiB, WS_W1 = 19 * MiB, WS_W2 = 27 * MiB, WS_TAB = 35 * MiB,
                 WS_BAR = 35 * MiB + 512 * 1024, WS_NSHIFT = 35 * MiB + 768 * 1024, WS_FUT = 124 * MiB, WS_MEMN = 36 * MiB, WS_MEMKV = 38 * MiB, WS_SSQ = 40 * MiB, WS_G = 44 * MiB, WS_Z = 140 * MiB, WS_H = 220 * MiB,
                 WS_MERGED = 140 * MiB, WS_XMB = 172 * MiB, WS_A = 44 * MiB, WS_END = 256 * MiB;
constexpr int LDS_BYTES = 147456;

typedef float f32x2_t __attribute__((ext_vector_type(2))); typedef __bf16 bf16x2_t __attribute__((ext_vector_type(2)));
__device__ __forceinline__ unsigned cvt_pk_bf16(float lo, float hi) { f32x2_t v = {lo, hi}; bf16x2_t b = __builtin_convertvector(v, bf16x2_t); return __builtin_bit_cast(unsigned, b); }
__device__ __forceinline__ float bf_lo(unsigned w) { return __uint_as_float(w << 16); }
__device__ __forceinline__ float bf_hi(unsigned w) { return __uint_as_float(w & 0xffff0000u); }
__device__ __forceinline__ float bf2f(bf16_t h) { return __uint_as_float(((unsigned)h) << 16); }
__device__ __forceinline__ float wave_sum(float v) {
#pragma unroll
    for (int o = 1; o < 64; o <<= 1) v += __shfl_xor(v, o);
    return v;
}
__device__ __forceinline__ float cosrev(float r) { return __builtin_amdgcn_cosf(r); }
__device__ __forceinline__ float sinrev(float r) { return __builtin_amdgcn_sinf(r); }
typedef __amdgpu_buffer_rsrc_t rsrc_t;
__device__ __forceinline__ rsrc_t mk_rsrc(const void* p) { return __builtin_amdgcn_make_buffer_rsrc((void*)p, 0, 0x7fffffff, 0x00020000); }
__device__ __forceinline__ void st16_wt(rsrc_t r, unsigned byte_off, u32x4 v) { __builtin_amdgcn_raw_buffer_store_b128(v, r, byte_off, 0, 16); }
#define MFMA16(a, b, c) __builtin_amdgcn_mfma_f32_16x16x32_bf16((a), (b), (c), 0, 0, 0)

namespace pg8 {
constexpr int BM = 256, BK = 64, HALF = 128, HTB = HALF * BK * 2, STAGE_BYTES = 8 * HTB, NXCD = 8, WGM = 8;
__host__ __device__ __forceinline__ int lds_byte(int r, int c) { const int st = (r >> 4) * 2 + (c >> 5), rr = r & 15, cc = c & 31, ob = rr * 64 + cc * 2; return st * 1024 + (ob ^ (((ob >> 9) & 1) << 5)); }
__host__ __device__ __forceinline__ void stage_rc(int b, int& R, int& C) { const int st = b / 1024, sb = b % 1024, swz = sb ^ (((sb >> 9) & 1) << 5); R = (st >> 1) * 16 + swz / 64; C = (st & 1) * 32 + (swz % 64) / 2; }
__host__ __device__ __forceinline__ int perm32(int rho) { const int n = rho >> 4, i = rho & 15; return 8 * (i >> 2) + 4 * n + (i & 3); }

struct Unit { int pm, pn, z; };
struct Gemm { const bf16_t* A0; const bf16_t* B0; const bf16_t* A1; const bf16_t* B1; int lda, ldb, K; const bf16_t* P2; size_t kstepA, kstepB; };

struct StaticOrder {
    int nM, nN, nwg, G, c;
    __device__ void init(int M_, int N_, int G_, int c_) { nM = M_ / BM; nN = N_ / BM; nwg = nM * nN; G = G_; c = c_; }
    __device__ __forceinline__ void map(int wgid, Unit& u) const {
        { const int q = nwg / NXCD, r = nwg % NXCD, xcd = wgid % NXCD, off = wgid / NXCD; wgid = (xcd < r ? xcd * (q + 1) : r * (q + 1) + (xcd - r) * q) + off; }
        const int nig = WGM * nN, gid = wgid / nig, fm = gid * WGM, gsz = (nM - fm) < WGM ? (nM - fm) : WGM;
        u.pm = fm + ((wgid % nig) % gsz); u.pn = (wgid % nig) / gsz; u.z = 0;
    }
    __device__ bool next(int i, Unit& u) const { const long L = (long)i * G + c; if (L >= nwg) return false; map((int)L, u); return true; }
};
struct ComboOrder {
    StaticOrder s; int extra, extra_nn, rot;
    __device__ bool next(int i, Unit& u) const {
        const long L = (long)i * s.G + s.c; if (L >= s.nwg + extra) return false;
        if (L < s.nwg) { s.map((int)L, u); u.pn = (u.pn + rot) % s.nN; } else { const int e = (int)L - s.nwg; u.pm = e / extra_nn; u.pn = e % extra_nn; u.z = 1; }
        return true;
    }
};

template <class Epi, class Sched, bool ALIGN_EPI, bool SEGA = false>
__device__ __forceinline__ void gemm_phase(LAS unsigned char* lds, const Gemm g, const Sched& S, const Epi& E) {
    const int tid = threadIdx.x, wid = __builtin_amdgcn_readfirstlane(tid >> 6), lane = tid & 63, wr = wid >> 2, wc = wid & 3, fr = lane & 15, fq = lane >> 4;
    const int K = g.K, nt = K / BK;
    unsigned voffA[2], voffB[2], voffA2[2];
#pragma unroll
    for (int i = 0; i < 2; ++i) { int R, C; stage_rc(tid * 16 + i * 8192, R, C); const int Rb = Epi::PERM ? ((R & ~31) + perm32(R & 31)) : R;
        voffA[i] = (unsigned)(R * g.lda + C) * 2u; voffB[i] = (unsigned)(Rb * g.ldb + C) * 2u; voffA2[i] = (unsigned)((C >> 3) * 4096 + R) * 16u; }
    const size_t kstep = g.kstepA, kstepB = g.kstepB;
    const size_t hstepA = (size_t)HALF * g.lda * 2, hstepB = (size_t)HALF * g.ldb * 2;
    const size_t tstepA = 2 * hstepA, tstepB = 2 * hstepB;
    const unsigned ldsw = (unsigned)wid * 1024u;
    const int aoff = lds_byte(wr * 64 + fr, fq * 8), boff = lds_byte(wc * 32 + fr, fq * 8);
#define PG8_SA(b, h) (((b) * 2 + (h)) * HTB)
#define PG8_SB(b, h) ((4 + (b) * 2 + (h)) * HTB)
#define PG8_STAGE(bufoff, gbase, voff) do { _Pragma("unroll") for (int _i = 0; _i < 2; ++_i) \
        __builtin_amdgcn_global_load_lds((const unsigned*)((const char*)(gbase) + (voff)[_i]), (LAS unsigned*)(lds + (bufoff) + ldsw + _i * 8192), 16, 0, 0); } while (0)
#define PG8_ASTAGE(bufoff, uA, uP, tile, half) do { const int tl_ = (tile); const char* gp_; unsigned o0_, o1_; \
        if (SEGA && (unsigned)(tl_ - 8) < 16u) { gp_ = (uP) + (size_t)(tl_ - 8) * 524288 + (half) * 2048; o0_ = voffA2[0]; o1_ = voffA2[1]; } \
        else { gp_ = (uA) + (size_t)tl_ * kstep + (size_t)(half) * hstepA; o0_ = voffA[0]; o1_ = voffA[1]; } \
        __builtin_amdgcn_global_load_lds((const unsigned*)(gp_ + o0_), (LAS unsigned*)(lds + (bufoff) + ldsw), 16, 0, 0); \
        __builtin_amdgcn_global_load_lds((const unsigned*)(gp_ + o1_), (LAS unsigned*)(lds + (bufoff) + ldsw + 8192), 16, 0, 0); } while (0)
#define PG8_UP2(pm_) ((const char*)g.P2 + ((size_t)((pm_) >> 4) * 128 * 4096 + (size_t)((pm_) & 15) * 256) * 16)
#define PG8_LDA(dst, b, h) do { _Pragma("unroll") for (int m = 0; m < 4; ++m) _Pragma("unroll") for (int k = 0; k < 2; ++k) dst[m][k] = *(const LAS bf16x8*)(lds + PG8_SA(b, h) + aoff + m * 2048 + k * 1024); } while (0)
#define PG8_LDB(dst, b, h) do { _Pragma("unroll") for (int n = 0; n < 2; ++n) _Pragma("unroll") for (int k = 0; k < 2; ++k) dst[n][k] = *(const LAS bf16x8*)(lds + PG8_SB(b, h) + boff + n * 2048 + k * 1024); } while (0)
#define PG8_MMA(ai, bj, At, Bt) do { __builtin_amdgcn_s_setprio(1); _Pragma("unroll") for (int m = 0; m < 4; ++m) _Pragma("unroll") for (int n = 0; n < 2; ++n) _Pragma("unroll") for (int k = 0; k < 2; ++k) \
        acc[ai][bj][m][n] = __builtin_amdgcn_mfma_f32_16x16x32_bf16(Bt[n][k], At[m][k], acc[ai][bj][m][n], 0, 0, 0); __builtin_amdgcn_s_setprio(0); } while (0)
#define PG8_WAIT_V(n) asm volatile("s_waitcnt vmcnt(" #n ")" ::: "memory")
#define PG8_WAIT_L(n) asm volatile("s_waitcnt lgkmcnt(" #n ")" ::: "memory")
#define PG8_BAR __builtin_amdgcn_s_barrier()
#define PG8_SCHED __builtin_amdgcn_sched_barrier(0)
    Unit cur, nxt; int ui = 0;
    if (!S.next(0, cur)) return;
    f32x4 acc[2][2][4][2];
#pragma unroll
    for (int a = 0; a < 2; ++a)
#pragma unroll
        for (int b = 0; b < 2; ++b)
#pragma unroll
            for (int m = 0; m < 4; ++m)
#pragma unroll
                for (int n = 0; n < 2; ++n) acc[a][b][m][n] = (f32x4){0.f, 0.f, 0.f, 0.f};
    bf16x8 At[4][2], B0[2][2], B1[2][2];
    const char* cA = (const char*)(cur.z ? g.A1 : g.A0) + (size_t)cur.pm * tstepA; const char* cB = (const char*)(cur.z ? g.B1 : g.B0) + (size_t)cur.pn * tstepB;
    const char* cP = SEGA ? PG8_UP2(cur.pm) : nullptr;
    PG8_STAGE(PG8_SB(0, 0), cB, voffB); PG8_STAGE(PG8_SB(0, 1), cB + hstepB, voffB); PG8_ASTAGE(PG8_SA(0, 0), cA, cP, 0, 0); PG8_ASTAGE(PG8_SA(0, 1), cA, cP, 0, 1);
    if (wr == 1) PG8_BAR;
    PG8_WAIT_V(2); PG8_BAR;
    PG8_STAGE(PG8_SB(1, 0), cB + kstepB, voffB); PG8_ASTAGE(PG8_SA(1, 0), cA, cP, 1, 0); PG8_STAGE(PG8_SB(1, 1), cB + hstepB + kstepB, voffB);
    PG8_WAIT_V(6); PG8_BAR;
    for (;;) {
        const bool has_next = S.next(ui + 1, nxt);
        const char* nA = has_next ? (const char*)(nxt.z ? g.A1 : g.A0) + (size_t)nxt.pm * tstepA : cA; const char* nB = has_next ? (const char*)(nxt.z ? g.B1 : g.B0) + (size_t)nxt.pn * tstepB : cB;
        const char* nP = (SEGA && has_next) ? PG8_UP2(nxt.pm) : cP;
        for (int t = 0; t < nt; t += 2) {
            if constexpr (Epi::HAS_MID) E.mid(acc, cur, t, wr, wc, fr, fq);
            const bool last = (t == nt - 2);
            const char* uA2 = last ? nA : cA; const char* uP2 = last ? nP : cP; const int t2 = last ? 0 : t + 2;
            const char* b2 = last ? nB : cB + (size_t)(t + 2) * kstepB; const char* b3 = b2 + kstepB;
            PG8_LDB(B0, 0, 0); PG8_LDB(B1, 0, 1); PG8_SCHED; PG8_LDA(At, 0, 0); PG8_ASTAGE(PG8_SA(1, 1), cA, cP, t + 1, 1);
            PG8_WAIT_V(8); PG8_WAIT_L(0); PG8_BAR; PG8_MMA(0, 0, At, B0); PG8_MMA(0, 1, At, B1); PG8_BAR; PG8_SCHED;
            PG8_LDA(At, 0, 1); PG8_STAGE(PG8_SB(0, 0), b2, voffB); PG8_STAGE(PG8_SB(0, 1), b2 + hstepB, voffB); PG8_ASTAGE(PG8_SA(0, 0), uA2, uP2, t2, 0);
            PG8_WAIT_V(8); PG8_WAIT_L(0); PG8_BAR; PG8_MMA(1, 0, At, B0); PG8_MMA(1, 1, At, B1); PG8_BAR; PG8_SCHED;
            PG8_LDB(B0, 1, 0); PG8_LDB(B1, 1, 1); PG8_SCHED; PG8_LDA(At, 1, 0); PG8_ASTAGE(PG8_SA(0, 1), uA2, uP2, t2, 1);
            PG8_WAIT_V(8); PG8_WAIT_L(0); PG8_BAR; PG8_MMA(0, 0, At, B0); PG8_MMA(0, 1, At, B1); PG8_BAR; PG8_SCHED;
            PG8_LDA(At, 1, 1); PG8_STAGE(PG8_SB(1, 0), b3, voffB); PG8_STAGE(PG8_SB(1, 1), b3 + hstepB, voffB); PG8_ASTAGE(PG8_SA(1, 0), uA2, uP2, t2 + 1, 0);
            PG8_WAIT_V(8); PG8_WAIT_L(0); PG8_BAR; PG8_MMA(1, 0, At, B0); PG8_MMA(1, 1, At, B1); PG8_BAR; PG8_SCHED;
        }
        if constexpr (ALIGN_EPI) { if (wr == 0) PG8_BAR; }
        E(acc, cur, wr, wc, fr, fq);
        if (!has_next) break;
#pragma unroll
        for (int a = 0; a < 2; ++a)
#pragma unroll
            for (int b = 0; b < 2; ++b)
#pragma unroll
                for (int m = 0; m < 4; ++m)
#pragma unroll
                    for (int n = 0; n < 2; ++n) acc[a][b][m][n] = (f32x4){0.f, 0.f, 0.f, 0.f};
        cur = nxt; cA = nA; cB = nB; cP = nP; ++ui;
        if constexpr (ALIGN_EPI) { if (wr == 1) PG8_BAR; }
    }
    PG8_WAIT_V(0);
    if constexpr (!ALIGN_EPI) { if (wr == 0) PG8_BAR; }
    PG8_BAR;
#undef PG8_SA
#undef PG8_SB
#undef PG8_STAGE
#undef PG8_LDA
#undef PG8_ASTAGE
#undef PG8_UP2
#undef PG8_LDB
#undef PG8_MMA
#undef PG8_WAIT_V
#undef PG8_WAIT_L
#undef PG8_BAR
#undef PG8_SCHED
}

typedef f32x4 Acc[2][2][4][2];

struct EpiInProj {
    static constexpr bool PERM = true, HAS_MID = false;
    bf16_t* Z; unsigned char* G; bf16_t* MKV; const float* bgate; const float* gq; const float* gk; LAS float* P; bf16_t* FUT;
    __device__ __forceinline__ void operator()(const Acc& acc, const Unit& u, int wr, int wc, int fr, int fq) const {
        const int row0 = u.pm * BM + wr * 64 + fr;
        if (u.z == 0 && u.pn >= NZ / BM) {
            const int col0 = (u.pn - NZ / BM) * BM + wc * 32 + 8 * fq;
            const float NL2E = -1.4426950408889634f, I255 = 1.0f / 255.0f;
            const int gtile = u.pn - NZ / BM;
            unsigned char* gt = G + ((size_t)(((gtile >> 2) * (M / BM) + u.pm) * 4 + (gtile & 3)) * 8 + (wr * 4 + wc)) * 8192 + (fq * 16 + fr) * 16;
            f32x4 bv[2][2];
#pragma unroll
            for (int bj = 0; bj < 2; ++bj)
#pragma unroll
                for (int n = 0; n < 2; ++n) bv[bj][n] = *(const f32x4*)(bgate + col0 + bj * HALF + 4 * n) * NL2E;
#pragma unroll
            for (int ai = 0; ai < 2; ++ai)
#pragma unroll
                for (int m = 0; m < 4; ++m) { u32x4 w16;
#pragma unroll
                    for (int bj = 0; bj < 2; ++bj) { u32x2 w; w.x = 0u; w.y = 0u;
#pragma unroll
                        for (int e = 0; e < 4; ++e) {
                            const float q0 = __builtin_rintf(fmaxf(__builtin_amdgcn_rcpf(fmaf(__builtin_amdgcn_exp2f(fmaf(acc[ai][bj][m][0][e], NL2E, bv[bj][0][e])), I255, I255)), 1.0f));
                            const float q1 = __builtin_rintf(fmaxf(__builtin_amdgcn_rcpf(fmaf(__builtin_amdgcn_exp2f(fmaf(acc[ai][bj][m][1][e], NL2E, bv[bj][1][e])), I255, I255)), 1.0f));
                            w.x = __builtin_amdgcn_cvt_pk_u8_f32(q0, e, w.x); w.y = __builtin_amdgcn_cvt_pk_u8_f32(q1, e, w.y); }
                        if (bj == 0) { w16.x = w.x; w16.y = w.y; } else { w16.z = w.x; w16.w = w.y; } }
                    *(u32x4*)(gt + (ai * 4 + m) * 1024) = w16; }
            return;
        }
        if (u.z == 0 && (u.pn == 6 || u.pn == 7)) {
            const int ch0 = (u.pn - 6) * BM + wc * 32 + 8 * fq;
#pragma unroll
            for (int ai = 0; ai < 2; ++ai)
#pragma unroll
                for (int m = 0; m < 4; ++m) { const int row = row0 + ai * HALF + m * 16, bb = row >> 12, tok = row & 4095;
#pragma unroll
                    for (int bj = 0; bj < 2; ++bj) { const f32x4 v0 = acc[ai][bj][m][0], v1 = acc[ai][bj][m][1]; const int cb0 = (ch0 + bj * HALF) >> 2;
                        u32x2 w0, w1; w0.x = cvt_pk_bf16(v0[0], v0[1]); w0.y = cvt_pk_bf16(v0[2], v0[3]); w1.x = cvt_pk_bf16(v1[0], v1[1]); w1.y = cvt_pk_bf16(v1[2], v1[3]);
                        *(u32x2*)(FUT + (((size_t)(bb * 128 + cb0) * 4096 + tok) * 4)) = w0; *(u32x2*)(FUT + (((size_t)(bb * 128 + cb0 + 1) * 4096 + tok) * 4)) = w1; } }
            return;
        }
        bf16_t* base; int ldc;
        if (u.z == 1) { base = MKV; ldc = D; } else { base = Z; ldc = NZ; }
        const int col0 = u.pn * BM + wc * 32 + 8 * fq;
        const bool qk = (u.z == 0) && (u.pn < 4);
        float rsn[2][4][2]; f32x4 g0 = (f32x4){1.f, 1.f, 1.f, 1.f}, g1 = g0;
        if (qk) {
#pragma unroll
            for (int ai = 0; ai < 2; ++ai)
#pragma unroll
                for (int m = 0; m < 4; ++m)
#pragma unroll
                    for (int bj = 0; bj < 2; ++bj) { const f32x4 a0 = acc[ai][bj][m][0], a1 = acc[ai][bj][m][1];
                        float ss = ((a0[0] * a0[0] + a0[1] * a0[1]) + (a0[2] * a0[2] + a0[3] * a0[3])) + ((a1[0] * a1[0] + a1[1] * a1[1]) + (a1[2] * a1[2] + a1[3] * a1[3]));
                        ss += __shfl_xor(ss, 16); ss += __shfl_xor(ss, 32);
                        if (fq == 0) P[(((ai * HALF + wr * 64 + m * 16 + fr) * 4 + 2 * bj + (wc >> 1)) * 2) + (wc & 1)] = ss; }
            asm volatile("s_waitcnt lgkmcnt(0)" ::: "memory"); __builtin_amdgcn_s_barrier(); asm volatile("" ::: "memory");
#pragma unroll
            for (int ai = 0; ai < 2; ++ai)
#pragma unroll
                for (int m = 0; m < 4; ++m)
#pragma unroll
                    for (int bj = 0; bj < 2; ++bj) { const LAS float* pp = P + (((ai * HALF + wr * 64 + m * 16 + fr) * 4 + 2 * bj + (wc >> 1)) * 2);
                        rsn[ai][m][bj] = rsqrtf((pp[0] + pp[1]) * (1.0f / 64.0f) + EPS); }
            if (u.pn < 2) { const int d0 = 32 * (wc & 1) + 8 * fq; const float sc = 0.125f * 1.4426950408889634f;
#pragma unroll
                for (int e = 0; e < 4; ++e) { g0[e] = gq[d0 + e] * gk[d0 + e] * sc; g1[e] = gq[d0 + 4 + e] * gk[d0 + 4 + e] * sc; } }
        } else {
#pragma unroll
            for (int ai = 0; ai < 2; ++ai)
#pragma unroll
                for (int m = 0; m < 4; ++m) { rsn[ai][m][0] = 1.f; rsn[ai][m][1] = 1.f; }
        }
#pragma unroll
        for (int ai = 0; ai < 2; ++ai)
#pragma unroll
            for (int m = 0; m < 4; ++m) { const unsigned ro = (unsigned)((row0 + ai * HALF + m * 16) * ldc + col0) * 2u;
#pragma unroll
                for (int bj = 0; bj < 2; ++bj) { const f32x4 v0 = acc[ai][bj][m][0] * rsn[ai][m][bj] * g0, v1 = acc[ai][bj][m][1] * rsn[ai][m][bj] * g1;
                    u32x4 w; w.x = cvt_pk_bf16(v0[0], v0[1]); w.y = cvt_pk_bf16(v0[2], v0[3]); w.z = cvt_pk_bf16(v1[0], v1[1]); w.w = cvt_pk_bf16(v1[2], v1[3]);
                    *(u32x4*)((char*)base + ro + bj * HALF * 2) = w; } }
    }
};

__device__ __forceinline__ float ub0(unsigned w) { return (float)(w & 0xffu); }
__device__ __forceinline__ float ub1(unsigned w) { return (float)((w >> 8) & 0xffu); }
__device__ __forceinline__ float ub2(unsigned w) { return (float)((w >> 16) & 0xffu); }
__device__ __forceinline__ float ub3(unsigned w) { return (float)(w >> 24); }
struct EpiMerge {
    static constexpr bool PERM = true, HAS_MID = true;
    const unsigned char* G; bf16_t* O;
    __device__ __forceinline__ const unsigned char* gimg(const Unit& u, int g, int wr, int wc, int fr, int fq) const {
        return G + ((size_t)((g * (M / BM) + u.pm) * 4 + u.pn) * 8 + (wr * 4 + wc)) * 8192 + (fq * 16 + fr) * 16; }
    __device__ __forceinline__ void rescale(Acc& acc, const Unit& u, int ga, int gb, int wr, int wc, int fr, int fq) const {
        const unsigned char* gpa = gimg(u, ga, wr, wc, fr, fq); const unsigned char* gpb = gimg(u, gb, wr, wc, fr, fq);
#pragma unroll
        for (int ai = 0; ai < 2; ++ai) {
            u32x4 a[4], b[4];
#pragma unroll
            for (int m = 0; m < 4; ++m) { a[m] = *(const u32x4*)(gpa + (ai * 4 + m) * 1024); b[m] = *(const u32x4*)(gpb + (ai * 4 + m) * 1024); }
#pragma unroll
            for (int m = 0; m < 4; ++m)
#pragma unroll
                for (int bj = 0; bj < 2; ++bj) { const unsigned ax = bj ? a[m].z : a[m].x, ay = bj ? a[m].w : a[m].y, bx = bj ? b[m].z : b[m].x, by = bj ? b[m].w : b[m].y;
                    f32x4 r0, r1;
                    r0[0] = ub0(ax) * __builtin_amdgcn_rcpf(ub0(bx)); r0[1] = ub1(ax) * __builtin_amdgcn_rcpf(ub1(bx)); r0[2] = ub2(ax) * __builtin_amdgcn_rcpf(ub2(bx)); r0[3] = ub3(ax) * __builtin_amdgcn_rcpf(ub3(bx));
                    r1[0] = ub0(ay) * __builtin_amdgcn_rcpf(ub0(by)); r1[1] = ub1(ay) * __builtin_amdgcn_rcpf(ub1(by)); r1[2] = ub2(ay) * __builtin_amdgcn_rcpf(ub2(by)); r1[3] = ub3(ay) * __builtin_amdgcn_rcpf(ub3(by));
                    acc[ai][bj][m][0] *= r0; acc[ai][bj][m][1] *= r1; }
            asm volatile("" ::: "memory");
        }
    }
    __device__ __forceinline__ void mid(Acc& acc, const Unit& u, int t, int wr, int wc, int fr, int fq) const {
        if (t == 8 || t == 24) { const int ga = (t == 8) ? 0 : 1; rescale(acc, u, ga, ga + 1, wr, wc, fr, fq); }
    }
    __device__ __forceinline__ void operator()(Acc& acc, const Unit& u, int wr, int wc, int fr, int fq) const {
        const int row0 = u.pm * BM + wr * 64 + fr, col0 = u.pn * BM + wc * 32 + 8 * fq;
        const float k = 1.0f / 255.0f; const rsrc_t ro_rs = mk_rsrc(O);
        const unsigned char* gp2 = gimg(u, 2, wr, wc, fr, fq);
#pragma unroll
        for (int ai = 0; ai < 2; ++ai) {
            u32x4 a[4];
#pragma unroll
            for (int m = 0; m < 4; ++m) a[m] = *(const u32x4*)(gp2 + (ai * 4 + m) * 1024);
#pragma unroll
            for (int m = 0; m < 4; ++m) { const unsigned ro = (unsigned)((row0 + ai * HALF + m * 16) * D + col0) * 2u;
#pragma unroll
                for (int bj = 0; bj < 2; ++bj) { const unsigned ax = bj ? a[m].z : a[m].x, ay = bj ? a[m].w : a[m].y; const f32x4 v0 = acc[ai][bj][m][0] * k, v1 = acc[ai][bj][m][1] * k;
                    u32x4 w; w.x = cvt_pk_bf16(v0[0] * ub0(ax), v0[1] * ub1(ax)); w.y = cvt_pk_bf16(v0[2] * ub2(ax), v0[3] * ub3(ax));
                    w.z = cvt_pk_bf16(v1[0] * ub0(ay), v1[1] * ub1(ay)); w.w = cvt_pk_bf16(v1[2] * ub2(ay), v1[3] * ub3(ay));
                    st16_wt(ro_rs, ro + bj * HALF * 2, w); } }
            asm volatile("" ::: "memory");
        }
    }
};

struct EpiWout {
    static constexpr bool PERM = true, HAS_MID = false;
    const float* X; bf16_t* XMB; float* SSQ; LAS float* P;
    __device__ __forceinline__ void operator()(const Acc& acc, const Unit& u, int wr, int wc, int fr, int fq) const {
        const int col0 = u.pn * BM + wc * 32 + 8 * fq; const rsrc_t xrs = mk_rsrc(XMB);
#pragma unroll
        for (int ai = 0; ai < 2; ++ai) {
            f32x4 xv[4][2][2];
#pragma unroll
            for (int m = 0; m < 4; ++m)
#pragma unroll
                for (int bj = 0; bj < 2; ++bj)
#pragma unroll
                    for (int n = 0; n < 2; ++n) xv[m][bj][n] = __builtin_nontemporal_load((const f32x4*)(X + (size_t)(u.pm * BM + ai * HALF + wr * 64 + m * 16 + fr) * D + col0 + bj * HALF + n * 4));
#pragma unroll
            for (int m = 0; m < 4; ++m) { const int rl = ai * HALF + wr * 64 + m * 16 + fr; const unsigned ro = (unsigned)((u.pm * BM + rl) * D + col0) * 2u; float s = 0.f;
#pragma unroll
                for (int bj = 0; bj < 2; ++bj) { const f32x4 o0 = xv[m][bj][0] + acc[ai][bj][m][0], o1 = xv[m][bj][1] + acc[ai][bj][m][1];
                    u32x4 w; w.x = cvt_pk_bf16(o0[0], o0[1]); w.y = cvt_pk_bf16(o0[2], o0[3]); w.z = cvt_pk_bf16(o1[0], o1[1]); w.w = cvt_pk_bf16(o1[2], o1[3]);
                    st16_wt(xrs, ro + bj * HALF * 2, w);
                    s += ((o0[0] * o0[0] + o0[1] * o0[1]) + (o0[2] * o0[2] + o0[3] * o0[3])) + ((o1[0] * o1[0] + o1[1] * o1[1]) + (o1[2] * o1[2] + o1[3] * o1[3])); }
                s += __shfl_xor(s, 16); s += __shfl_xor(s, 32);
                if (fq == 0) P[rl * 4 + wc] = s; }
            asm volatile("" ::: "memory");
        }
        asm volatile("s_waitcnt lgkmcnt(0)" ::: "memory"); __builtin_amdgcn_s_barrier(); asm volatile("" ::: "memory");
        const int t = threadIdx.x;
        if (t < 256) { const f32x4 pv = *(const LAS f32x4*)(P + t * 4); SSQ[(size_t)(u.pm * BM + t) * 4 + u.pn] = (pv[0] + pv[1]) + (pv[2] + pv[3]); }
        asm volatile("s_waitcnt lgkmcnt(0)" ::: "memory"); __builtin_amdgcn_s_barrier(); asm volatile("" ::: "memory");
    }
};

struct EpiFfn1 {
    static constexpr bool PERM = true, HAS_MID = false;
    const float* SSQ; bf16_t* O; LAS float* RS;
    __device__ __forceinline__ void operator()(const Acc& acc, const Unit& u, int wr, int wc, int fr, int fq) const {
        volatile LAS int* cpm = (volatile LAS int*)(RS + 256);
        if (*cpm != u.pm) {
            __builtin_amdgcn_s_barrier();
            const int t = threadIdx.x;
            if (t < 256) { const f32x4 s4 = *(const f32x4*)(SSQ + (size_t)(u.pm * BM + t) * 4); RS[t] = rsqrtf(((s4[0] + s4[1]) + (s4[2] + s4[3])) * (1.0f / D) + EPS); }
            if (t == 0) *cpm = u.pm;
            asm volatile("s_waitcnt vmcnt(0) lgkmcnt(0)" ::: "memory"); __builtin_amdgcn_s_barrier(); asm volatile("" ::: "memory");
        }
        const int rl0 = wr * 64 + fr, col0 = u.pn * BM + wc * 32 + 8 * fq; const rsrc_t ors = mk_rsrc(O);
#pragma unroll
        for (int ai = 0; ai < 2; ++ai)
#pragma unroll
            for (int m = 0; m < 4; ++m) { const int rl = rl0 + ai * HALF + m * 16, row = u.pm * BM + rl; const float rs = RS[rl];
                const unsigned ro = (unsigned)((((size_t)(col0 >> 6) * M + row) * 64 + (col0 & 63)) * 2);
#pragma unroll
                for (int bj = 0; bj < 2; ++bj) { f32x4 v0 = acc[ai][bj][m][0] * rs, v1 = acc[ai][bj][m][1] * rs;
#pragma unroll
                    for (int e = 0; e < 4; ++e) { const float a = fmaxf(v0[e], 0.f), b = fmaxf(v1[e], 0.f); v0[e] = a * a; v1[e] = b * b; }
                    u32x4 w; w.x = cvt_pk_bf16(v0[0], v0[1]); w.y = cvt_pk_bf16(v0[2], v0[3]); w.z = cvt_pk_bf16(v1[0], v1[1]); w.w = cvt_pk_bf16(v1[2], v1[3]);
                    st16_wt(ors, ro + (unsigned)bj * (2u * M * 64u * 2u), w); } }
    }
};

struct EpiFfn2 {
    static constexpr bool PERM = false, HAS_MID = false;
    const bf16_t* XMB; float* O;
    __device__ __forceinline__ void operator()(const Acc& acc, const Unit& u, int wr, int wc, int fr, int fq) const {
        const int col0 = u.pn * BM + wc * 32 + 4 * fq;
        u32x2 xb[2][4][2][2];
#pragma unroll
        for (int ai = 0; ai < 2; ++ai)
#pragma unroll
            for (int m = 0; m < 4; ++m) { const size_t off = (size_t)(u.pm * BM + ai * HALF + wr * 64 + m * 16 + fr) * D + col0;
#pragma unroll
                for (int bj = 0; bj < 2; ++bj)
#pragma unroll
                    for (int n = 0; n < 2; ++n) xb[ai][m][bj][n] = *(const u32x2*)(XMB + off + bj * HALF + n * 16); }
#pragma unroll
        for (int ai = 0; ai < 2; ++ai)
#pragma unroll
            for (int m = 0; m < 4; ++m) { const size_t off = (size_t)(u.pm * BM + ai * HALF + wr * 64 + m * 16 + fr) * D + col0;
#pragma unroll
                for (int bj = 0; bj < 2; ++bj)
#pragma unroll
                    for (int n = 0; n < 2; ++n) { const u32x2 w = xb[ai][m][bj][n];
                        f32x4 xv; xv[0] = bf_lo(w.x); xv[1] = bf_hi(w.x); xv[2] = bf_lo(w.y); xv[3] = bf_hi(w.y);
                        *(f32x4*)(O + off + bj * HALF + n * 16) = xv + acc[ai][bj][m][n]; } }
    }
};
}

struct Params {
    const float *x, *mem, *norm1_g, *w_in, *b_gate, *na_q_g, *na_k_g, *na_rpb, *w_na_o, *w_f, *mem_norm_g, *w_mem_kv, *mem_q_g, *mem_k_g, *w_mem_o, *w_out, *norm2_g, *w_ff1, *w_ff2;
    float* out; unsigned char* ws; int ph_lo, ph_hi;
};

__device__ __forceinline__ unsigned f2bf(float f) { unsigned u = __builtin_bit_cast(unsigned, f); return (u + 0x7fffu + ((u >> 16) & 1u)) >> 16; }
__device__ __forceinline__ unsigned pk2(float lo, float hi) { return f2bf(lo) | (f2bf(hi) << 16); }

__device__ __forceinline__ void p0_transpose_item(const float* W, int N, bf16_t* WT, int ldo, int col_off, const float* kscale, LAS float* scr, int item, int lane, size_t ktstride = 0) {
    const int nblk = N / 32, kb = item / nblk, nb = item % nblk, k0 = 64 * kb, n0 = 32 * nb;
    f32x4 v[8];
#pragma unroll
    for (int i = 0; i < 8; ++i) { const int kk = i * 8 + (lane >> 3); v[i] = __builtin_nontemporal_load((const f32x4*)(W + (size_t)(k0 + kk) * N + n0 + (lane & 7) * 4)); }
#pragma unroll
    for (int i = 0; i < 8; ++i) { const int kk = i * 8 + (lane >> 3); const float sc = kscale ? kscale[k0 + kk] : 1.0f; LAS float* d = scr + kk * 33 + (lane & 7) * 4;
        d[0] = v[i][0] * sc; d[1] = v[i][1] * sc; d[2] = v[i][2] * sc; d[3] = v[i][3] * sc; }
    asm volatile("s_waitcnt lgkmcnt(0)" ::: "memory");
    const int c = lane & 7;
#pragma unroll
    for (int j = 0; j < 4; ++j) { const int n = (lane >> 3) + 8 * j; const LAS float* s = scr + (8 * c) * 33 + n;
        u32x4 o; o.x = pk2(s[0 * 33], s[1 * 33]); o.y = pk2(s[2 * 33], s[3 * 33]); o.z = pk2(s[4 * 33], s[5 * 33]); o.w = pk2(s[6 * 33], s[7 * 33]);
        bf16_t* dp = ktstride ? (WT + (size_t)kb * ktstride + (size_t)(n0 + n) * 64 + 8 * c) : (WT + (size_t)(n0 + n) * ldo + col_off + k0 + 8 * c);
        *(u32x4*)dp = o; }
    asm volatile("s_waitcnt lgkmcnt(0)" ::: "memory");
}
__device__ __forceinline__ void rms_rows4_to_bf16(const float* xrow, const float* gvec, bf16_t* orow, int lane) {
    const f32x4* gr = (const f32x4*)gvec + lane;
    f32x4 v[4][4]; float s[4];
#pragma unroll
    for (int r = 0; r < 4; ++r)
#pragma unroll
        for (int j = 0; j < 4; ++j) v[r][j] = __builtin_nontemporal_load((const f32x4*)(xrow + (size_t)r * D) + lane + 64 * j);
#pragma unroll
    for (int r = 0; r < 4; ++r) { s[r] = 0.f;
#pragma unroll
        for (int j = 0; j < 4; ++j) s[r] += (v[r][j][0] * v[r][j][0] + v[r][j][1] * v[r][j][1]) + (v[r][j][2] * v[r][j][2] + v[r][j][3] * v[r][j][3]); }
#pragma unroll
    for (int o = 1; o < 64; o <<= 1) {
#pragma unroll
        for (int r = 0; r < 4; ++r) s[r] += __shfl_xor(s[r], o); }
    f32x4 gg[4];
#pragma unroll
    for (int j = 0; j < 4; ++j) gg[j] = gr[64 * j];
#pragma unroll
    for (int r = 0; r < 4; ++r) { const float rs = rsqrtf(s[r] * (1.0f / D) + EPS); u32x2* o8 = (u32x2*)(orow + (size_t)r * D) + lane;
#pragma unroll
        for (int j = 0; j < 4; ++j) { u32x2 w; w.x = pk2(v[r][j][0] * rs * gg[j][0], v[r][j][1] * rs * gg[j][1]); w.y = pk2(v[r][j][2] * rs * gg[j][2], v[r][j][3] * rs * gg[j][3]); o8[64 * j] = w; } }
}

#define XB_TMO      128
#define XB_XCNT(j)  (256  + 64 * (j))
#define XB_XSUB(j)  (1280 + 64 * (j))
#define XB_XGEN(j)  (2304 + 64 * (j))
#define XB_TOP      3328
#define XB_TOPGEN   3392
#define XCD_BAR_WORDS 3456
#define XB_SPIN_CAP (1u << 20)
__device__ __forceinline__ unsigned xb_ld(unsigned* p)              { return __hip_atomic_load(p, __ATOMIC_RELAXED, __HIP_MEMORY_SCOPE_AGENT); }
__device__ __forceinline__ unsigned xb_add(unsigned* p, unsigned v) { return __hip_atomic_fetch_add(p, v, __ATOMIC_RELAXED, __HIP_MEMORY_SCOPE_AGENT); }
__device__ __forceinline__ unsigned xb_xcc_id() { return (unsigned)__builtin_amdgcn_s_getreg((3 << 11) | 20) & 0xFu; }
#define XB_SPIN(cond, bar) do { unsigned _sp = 0; while (cond) { __builtin_amdgcn_s_sleep(1); \
    if ((++_sp & 255u) == 0u) { if (xb_ld(&(bar)[XB_TMO])) break; if (_sp > XB_SPIN_CAP) { atomicAdd(&(bar)[XB_TMO], 1u); break; } } } } while (0)
struct XcdBarrier { unsigned* bar; unsigned x; volatile LAS unsigned* st; };
__device__ __forceinline__ XcdBarrier xcd_barrier_post(unsigned* bar, volatile LAS unsigned* st) {
    XcdBarrier b; b.bar = bar; b.x = xb_xcc_id(); b.st = st;
    if (threadIdx.x == 0) (void)xb_add(&bar[XB_XCNT(b.x)], 1u);
    return b;
}
__device__ __forceinline__ void xcd_barrier_complete(unsigned* bar, unsigned x, unsigned& nloc, unsigned& nx) {
    const unsigned G = gridDim.x * gridDim.y * gridDim.z;
    unsigned sum, cnt, mine, sp = 0u;
    for (;;) {
        sum = 0u; cnt = 0u; mine = 0u;
#pragma unroll
        for (unsigned j = 0; j < 16; ++j) { const unsigned c = xb_ld(&bar[XB_XCNT(j)]); sum += c; cnt += (c > 0u) ? 1u : 0u; mine = (j == x) ? c : mine; }
        if (sum == G) break;
        __builtin_amdgcn_s_sleep(1);
        if ((++sp & 255u) == 0u) { if (xb_ld(&bar[XB_TMO])) break; if (sp > XB_SPIN_CAP) { atomicAdd(&bar[XB_TMO], 1u); break; } }
    }
    nloc = mine > 0u ? mine : 1u; nx = cnt > 0u ? cnt : 1u;
}
__device__ __forceinline__ void xcd_barrier(const XcdBarrier& b) {
    asm volatile("s_waitcnt vmcnt(0)" ::: "memory");
    __syncthreads();
    if (threadIdx.x == 0) {
        unsigned* bar = b.bar;
        __builtin_amdgcn_s_waitcnt(0);
        unsigned nloc = b.st[0], nx = b.st[1];
        if (nloc == 0u) { xcd_barrier_complete(bar, b.x, nloc, nx); b.st[0] = nloc; b.st[1] = nx; }
        const unsigned old = xb_add(&bar[XB_XSUB(b.x)], 1u);
        const unsigned gen = old / nloc;
        if (old + 1u == (gen + 1u) * nloc) {
            __builtin_amdgcn_fence(__ATOMIC_RELEASE, "agent");
            asm volatile("s_waitcnt vmcnt(0)" ::: "memory");
            const unsigned og = xb_add(&bar[XB_TOP], 1u);
            const unsigned tg = og / nx;
            if (og + 1u == (tg + 1u) * nx) xb_add(&bar[XB_TOPGEN], 1u);
            else XB_SPIN(xb_ld(&bar[XB_TOPGEN]) == tg, bar);
            __builtin_amdgcn_fence(__ATOMIC_ACQUIRE, "agent");
            xb_add(&bar[XB_XGEN(b.x)], 1u);
            asm volatile("s_waitcnt vmcnt(0)" ::: "memory");
        } else {
            XB_SPIN(xb_ld(&bar[XB_XGEN(b.x)]) == gen, bar);
            __builtin_amdgcn_fence(__ATOMIC_ACQUIRE, "agent");
            asm volatile("s_waitcnt vmcnt(0)" ::: "memory");
        }
    }
    __syncthreads();
}

__global__ void __launch_bounds__(512, 2) fwd_kernel(Params p) {
    extern __shared__ __attribute__((aligned(16))) unsigned char lds_raw[];
    LAS unsigned char* lds = (LAS unsigned char*)lds_raw;
    const int tid = threadIdx.x, lane = tid & 63, wave = __builtin_amdgcn_readfirstlane(tid >> 6);
    const int G = gridDim.x, bid = blockIdx.x;
    unsigned char* ws = p.ws;
    bf16_t* WinT = (bf16_t*)(ws + WS_WIN); bf16_t* WkvT = (bf16_t*)(ws + WS_WKV); bf16_t* Wcat = (bf16_t*)(ws + WS_WCAT); bf16_t* WoutT = (bf16_t*)(ws + WS_WOUT);
    bf16_t* W1T = (bf16_t*)(ws + WS_W1); bf16_t* W2T = (bf16_t*)(ws + WS_W2);
    bf16_t* D1f = (bf16_t*)(ws + WS_TAB); bf16_t* D2f = D1f + 8192;
    bf16_t* memn = (bf16_t*)(ws + WS_MEMN); bf16_t* memkv = (bf16_t*)(ws + WS_MEMKV); float* ssq = (float*)(ws + WS_SSQ);
    unsigned char* gbuf = (unsigned char*)(ws + WS_G); bf16_t* zbuf = (bf16_t*)(ws + WS_Z); bf16_t* hbuf = (bf16_t*)(ws + WS_H);
    bf16_t* merged = (bf16_t*)(ws + WS_MERGED); bf16_t* xmb = (bf16_t*)(ws + WS_XMB); bf16_t* abuf = (bf16_t*)(ws + WS_A);
    bf16_t* pimg = hbuf;
    bf16_t* fuT = (bf16_t*)(ws + WS_FUT);
    bf16_t* act = (bf16_t*)p.out;

    const int lo = p.ph_lo, hi = p.ph_hi;
#ifdef ONLY_PHASE
#define IN(k) ((k) == ONLY_PHASE && lo <= (k) && (k) < hi)
#else
#define IN(k) (lo <= (k) && (k) < hi)
#endif
#define BOTH(k) (IN(k) && IN((k) + 1))
#define CG_SYNC() do { asm volatile("s_waitcnt vmcnt(0) lgkmcnt(0)" ::: "memory"); __syncthreads(); cg::this_grid().sync(); \
        if (threadIdx.x == 0) { __builtin_amdgcn_fence(__ATOMIC_ACQUIRE, "agent"); asm volatile("s_waitcnt vmcnt(0)" ::: "memory"); } __syncthreads(); } while (0)
#define GRID_SYNC() do { xcd_barrier(xbar); } while (0)
    volatile LAS unsigned* xst = (volatile LAS unsigned*)(lds + LDS_BYTES - 16);
    if (tid == 0) { xst[0] = 0u; xst[1] = 0u; }
    __syncthreads();
    XcdBarrier xbar = xcd_barrier_post((unsigned*)(ws + WS_BAR), xst);

    if (IN(0)) for (int rep_ = 0; rep_ < NREP(0); ++rep_) {
        if (rep_) GRID_SYNC();
        LAS float* scr = (LAS float*)(lds + wave * 16384);
        LAS float* ctab = (LAS float*)(lds + 131072);
        if (tid < 128) { ctab[tid] = cosrev((float)tid * (1.0f / 128.0f)); ctab[128 + tid] = sinrev((float)tid * (1.0f / 128.0f)); }
        __syncthreads();
        const int gw = bid * 8 + wave, NGW = G * 8;
        constexpr int I_IN = 16 * (NIN / 32), I_KV = 16 * 32;
        for (int it = gw; it < I_IN + I_KV; it += NGW) {
            if (it < I_IN) p0_transpose_item(p.w_in, NIN, WinT, D, 0, nullptr, scr, it, lane);
            else p0_transpose_item(p.w_mem_kv, D, WkvT, D, 0, nullptr, scr, it - I_IN, lane);
        }
        for (int m = gw * 4; m < M + MROWS; m += NGW * 4) {
            if (m < M) rms_rows4_to_bf16(p.x + (size_t)m * D, p.norm1_g, hbuf + (size_t)m * D, lane);
            else rms_rows4_to_bf16(p.mem + (size_t)(m - M) * D, p.mem_norm_g, memn + (size_t)(m - M) * D, lane);
        }
        for (int it = gw; it < 2048; it += NGW) {
            const int g = it >> 9, nb = (it >> 3) & 63, c0 = (it & 7) * 16, li = lane & 15, lk = lane >> 4, c = c0 + li;
            const float* wsrc = p.w_f + (size_t)(g * 128 + lk) * D + nb * 16 + li;
            f32x4 aC = (f32x4){0.f, 0.f, 0.f, 0.f}, aS = (f32x4){0.f, 0.f, 0.f, 0.f};
#pragma unroll 8
            for (int ks = 0; ks < 32; ++ks) { const float a = wsrc[(size_t)(4 * ks) * D]; const int idx = (c * (4 * ks + lk)) & 127;
                aC = __builtin_amdgcn_mfma_f32_16x16x4f32(a, ctab[idx], aC, 0, 0, 0); aS = __builtin_amdgcn_mfma_f32_16x16x4f32(a, ctab[128 + idx], aS, 0, 0, 0); }
            const float sc = 0.08838834764831845f;
            bf16_t* dst = Wcat + (size_t)(nb * 16 + 4 * lk) * 2048 + 512 + (g * 32 + (c >> 2)) * 8 + 2 * (c & 3);
#pragma unroll
            for (int e = 0; e < 4; ++e) *(unsigned*)(dst + (size_t)e * 2048) = pk2(aC[e] * sc, aS[e] * sc);
        }
        for (int e = bid * 512 + tid; e < 8192 + 16384; e += G * 512) {
            if (e < 8192) { const int j = e & 7, ln = (e >> 3) & 63, ks = (e >> 9) & 1, mb = e >> 10; const int r = ln & 15, gq = ln >> 4;
                const int kb = 16 * (mb >> 1) + r, part = mb & 1, sb = ks * 32 + 8 * gq + j; const float rev = (float)((kb * sb) & 63) * (1.0f / 64.0f);
                D1f[e] = (bf16_t)f2bf(part ? -sinrev(rev) : cosrev(rev)); }
            else { const int e2 = e - 8192; const int j = e2 & 7, ln = (e2 >> 3) & 63, ks = (e2 >> 9) & 3, mb = e2 >> 11; const int r = ln & 15, gq = ln >> 4;
                const int o = r & 1, ka = 8 * mb + (r >> 1), k = ks * 32 + 8 * gq + j, sa = k >> 1, i = k & 1; const float rev = (float)((ka * sa) & 63) * (1.0f / 64.0f);
                const float cv = cosrev(rev), sv = sinrev(rev); const float val = (o == 0) ? (i == 0 ? cv : sv) : (i == 0 ? -sv : cv);
                D2f[e2] = (bf16_t)f2bf(val); }
        }
        __syncthreads();
    }
    if (BOTH(0)) GRID_SYNC();
    if (p.ph_lo == 0x7fffffff) CG_SYNC();

    if (IN(1)) for (int rep_ = 0; rep_ < NREP(1); ++rep_) {
        if (rep_) GRID_SYNC();
        pg8::Gemm g{hbuf, WinT, memn, WkvT, D, D, D, nullptr, 128, 128};
        pg8::ComboOrder S; S.s.init(M, NIN, G, bid); S.extra = (MROWS / 256) * (D / 256); S.extra_nn = D / 256; S.rot = 10;
        pg8::EpiInProj E{zbuf, gbuf, memkv, p.b_gate, p.na_q_g, p.na_k_g, (LAS float*)(lds + 131072), fuT};
        pg8::gemm_phase<pg8::EpiInProj, pg8::ComboOrder, true>(lds, g, S, E);
        {
            constexpr int NTILES = (M / 256) * (NIN / 256) + (MROWS / 256) * (D / 256);
            const int nfull = NTILES % G;
            int nw = G - nfull, first = nfull; if (nfull == 0 || nw < 32) { nw = G; first = 0; }
            if (bid >= first) {
                LAS float* scr = (LAS float*)(lds + wave * 16384);
                if (bid == G - 1 && wave == 0) {
                    float mg = fabsf(p.na_q_g[lane] * p.na_k_g[lane]), mb_ = 0.f;
                    for (int e = lane; e < 8 * 465; e += 64) mb_ = fmaxf(mb_, fabsf(p.na_rpb[e]));
#pragma unroll
                    for (int o = 1; o < 64; o <<= 1) { mg = fmaxf(mg, __shfl_xor(mg, o)); mb_ = fmaxf(mb_, __shfl_xor(mb_, o)); }
                    if (lane == 0) *(float*)(ws + WS_NSHIFT) = 8.0f * mg + mb_;
                }
                const int gw = (bid - first) * 8 + wave, NGW = nw * 8;
                constexpr int I_NAO = 8 * 32, I_MO = 8 * 32, I_OUT = 16 * 32, I_1 = 16 * (FF / 32), I_2 = 64 * 32;
                constexpr int NT_ITEMS = I_NAO + I_MO + I_OUT + I_1 + I_2;
                for (int it = gw; it < NT_ITEMS; it += NGW) {
                    int r = it;
                    if (r < I_NAO) { p0_transpose_item(p.w_na_o, D, Wcat, 2048, 0, nullptr, scr, r, lane); continue; } r -= I_NAO;
                    if (r < I_MO) { p0_transpose_item(p.w_mem_o, D, Wcat, 2048, 1536, nullptr, scr, r, lane); continue; } r -= I_MO;
                    if (r < I_OUT) { p0_transpose_item(p.w_out, D, WoutT, D, 0, nullptr, scr, r, lane); continue; } r -= I_OUT;
                    if (r < I_1) { p0_transpose_item(p.w_ff1, FF, W1T, D, 0, p.norm2_g, scr, r, lane); continue; } r -= I_1;
                    p0_transpose_item(p.w_ff2, D, W2T, FF, 0, nullptr, scr, r, lane, (size_t)D * 64);
                }

                __syncthreads();
            }
        }
    }
    if (BOTH(1)) GRID_SYNC();

    if (IN(2)) for (int rep_ = 0; rep_ < NREP(2); ++rep_) {
        if (rep_) GRID_SYNC();
        const int vb = (G % 8 == 0) ? (bid & 7) * (G >> 3) + (bid >> 3) : bid;
        const bool al = (G == 256); const int xq = bid & 7, jq = bid >> 3;
#ifndef NO_NA
        for (int rm_ = 0; rm_ < ((DUP_MIX == 0) ? 2 : 1); ++rm_) {
            int lane_o = lane, tid_o = tid; asm volatile("" : "+v"(lane_o), "+v"(tid_o)); const int q16 = lane_o & 15, g4 = lane_o >> 4;
            const int hs = wave >> 2, rsel = (wave >> 1) & 1, qp = wave & 1;
            LAS float* sbias = (LAS float*)(lds + 65536);
            LAS float* bpad = (LAS float*)(lds + 69632);
            for (int e = tid_o; e < 465; e += 512) bpad[e] = -1e30f;
            int hq_prev = -1;
            int boff[2][2][4];
#pragma unroll
            for (int qbi = 0; qbi < 2; ++qbi) { const int qb = 2 * qp + qbi; const int kstart = (qb == 0) ? 0 : (qb == 1) ? 8 : (qb == 2) ? 24 : 32; const int c = 16 * qb + q16, cs = min(max(c - 8, 0), 48);
#pragma unroll
                for (int kb = 0; kb < 2; ++kb)
#pragma unroll
                    for (int e = 0; e < 4; ++e) { const int kc = kstart + 16 * kb + 4 * g4 + e; const bool valid = (kc >= cs) && (kc < cs + 16);
                        boff[qbi][kb][e] = valid ? (65536 + (hs * 465 + (kc - c + 15)) * 4) : 69632; } }
            for (int un = vb, kq = 0; un < BATCH * 32 * 4; un += G, ++kq) {
                int b = un >> 7, rp = (un >> 2) & 31, hq = un & 3;
                if (al) { const int lu = kq * 32 + jq; b = xq >> 1; rp = 16 * (xq & 1) + (lu >> 2); hq = lu & 3; }
                const int h = hq * 2 + hs, r = 2 * rp + rsel;
                const int rs_r = min(max(r - 4, 0), 56), kr_lo = min(max(2 * rp - 4, 0), 56), nrows = min(max(2 * rp + 1 - 4, 0), 56) + 8 - kr_lo;
                const size_t tok0 = (size_t)b * SEQ;
                __syncthreads();
                if (hq != hq_prev) { const float nshift = *(const float*)(ws + WS_NSHIFT);
                    for (int e = tid_o; e < 2 * 465; e += 512) sbias[e] = (p.na_rpb[hq * 2 * 465 + e] - nshift) * 1.4426950408889634f; hq_prev = hq; }
                u32x4 kreg[2][2], vreg[2][2];
#define NA_LOAD_ROW(kr_, st_) do { const size_t kt_ = tok0 + (size_t)(kr_) * 64; _Pragma("unroll") for (int i = 0; i < 2; ++i) { const int cid = i * 512 + tid_o, key = (cid >> 3) & 63, ch = cid & 7, hsl = cid >> 9; \
                        const bf16_t* sp_ = zbuf + (kt_ + key) * NZ + (hq * 2 + hsl) * 64 + ch * 8; kreg[st_][i] = *(const u32x4*)(sp_ + OFF_K); vreg[st_][i] = *(const u32x4*)(sp_ + OFF_V); } } while (0)
#define NA_WRITE_ROW(buf_, st_) do { _Pragma("unroll") for (int i = 0; i < 2; ++i) { const int cid = i * 512 + tid_o, key = (cid >> 3) & 63, ch = cid & 7, hsl = cid >> 9; \
                        LAS unsigned char* kb_ = lds + (buf_) * 32768 + hsl * 16384 + key * 128 + ((ch ^ (key & 7)) * 16); \
                        *(LAS u32x4*)kb_ = kreg[st_][i]; *(LAS u32x4*)(kb_ + 8192) = vreg[st_][i]; } } while (0)
                NA_LOAD_ROW(kr_lo, 0); NA_LOAD_ROW(kr_lo + 1, 1);
                bf16x8 qf[2][2];
#pragma unroll
                for (int qbi = 0; qbi < 2; ++qbi) {
                    const int qb = 2 * qp + qbi;
                    const bf16_t* src = zbuf + (tok0 + r * 64 + 16 * qb + q16) * NZ + OFF_Q + h * 64;
                    qf[qbi][0] = *(const bf16x8*)(src + 8 * g4); qf[qbi][1] = *(const bf16x8*)(src + 32 + 8 * g4);
                }
                NA_WRITE_ROW(0, 0);
                float lrun[2]; f32x4 O[2][4];
#pragma unroll
                for (int qbi = 0; qbi < 2; ++qbi) { lrun[qbi] = 0.f;
#pragma unroll
                    for (int db = 0; db < 4; ++db) O[qbi][db] = (f32x4){0.f, 0.f, 0.f, 0.f}; }
                asm volatile("s_waitcnt lgkmcnt(0)" ::: "memory"); __builtin_amdgcn_s_barrier(); asm volatile("" ::: "memory");
#define NA_ROW(i_, cur_) do { const int kr = kr_lo + (i_); \
                    if ((i_) + 2 < nrows) NA_LOAD_ROW(kr + 2, cur_); \
                    if (kr >= rs_r && kr < rs_r + 8) {            \
                        const LAS unsigned char* Kb = lds + (cur_) * 32768 + hs * 16384; const LAS unsigned char* Vb = Kb + 8192; \
                        const int dr124 = (kr - r + 7) * 124; \
                        _Pragma("unroll") for (int qbi = 0; qbi < 2; ++qbi) { \
                            const int qb = 2 * qp + qbi; const int kstart = (qb == 0) ? 0 : (qb == 1) ? 8 : (qb == 2) ? 24 : 32; \
                            float pe[2][4]; float ps = 0.f; \
                            _Pragma("unroll") for (int kb = 0; kb < 2; ++kb) { \
                                const int key = kstart + 16 * kb + q16, sw = key & 7; \
                                const bf16x8 k0 = *(const LAS bf16x8*)(Kb + key * 128 + ((g4 ^ sw) * 16)), k1 = *(const LAS bf16x8*)(Kb + key * 128 + (((4 + g4) ^ sw) * 16)); \
                                f32x4 sa = (f32x4){0.f, 0.f, 0.f, 0.f}; \
                                sa = MFMA16(k0, qf[qbi][0], sa); sa = MFMA16(k1, qf[qbi][1], sa); \
                                _Pragma("unroll") for (int e = 0; e < 4; ++e) { const float bv = *(const LAS float*)(lds + boff[qbi][kb][e] + dr124); pe[kb][e] = __builtin_amdgcn_exp2f(sa[e] + bv); ps += pe[kb][e]; } \
                            } \
                            lrun[qbi] += ps; \
                            u32x4 pw; pw.x = cvt_pk_bf16(pe[0][0], pe[0][1]); pw.y = cvt_pk_bf16(pe[0][2], pe[0][3]); pw.z = cvt_pk_bf16(pe[1][0], pe[1][1]); pw.w = cvt_pk_bf16(pe[1][2], pe[1][3]); \
                            const bf16x8 pf = __builtin_bit_cast(bf16x8, pw); \
                            const int qq = q16 >> 2, pp = q16 & 3; \
                            const int rlo = kstart + 4 * g4 + qq, rhi = rlo + 16; \
                            _Pragma("unroll") for (int db = 0; db < 4; ++db) { \
                                const int chv = db * 2 + (pp >> 1), sub = (pp & 1) * 8; \
                                const s16x4 lo4 = __builtin_amdgcn_ds_read_tr16_b64_v4i16((LAS s16x4*)(Vb + rlo * 128 + ((chv ^ (rlo & 7)) * 16) + sub)); \
                                const s16x4 hi4 = __builtin_amdgcn_ds_read_tr16_b64_v4i16((LAS s16x4*)(Vb + rhi * 128 + ((chv ^ (rhi & 7)) * 16) + sub)); \
                                const bf16x8 vf = __builtin_shufflevector(lo4, hi4, 0, 1, 2, 3, 4, 5, 6, 7); \
                                O[qbi][db] = MFMA16(vf, pf, O[qbi][db]); \
                            } \
                        } \
                    } \
                    if ((i_) + 1 < nrows) NA_WRITE_ROW((cur_) ^ 1, (cur_) ^ 1); \
                    asm volatile("s_waitcnt lgkmcnt(0)" ::: "memory"); __builtin_amdgcn_s_barrier(); asm volatile("" ::: "memory"); } while (0)
#pragma unroll 1
                for (int i2 = 0; i2 < 10; i2 += 2) {
                    if (i2 < nrows) NA_ROW(i2, 0);
                    if (i2 + 1 < nrows) NA_ROW(i2 + 1, 1);
                }
#undef NA_ROW
#undef NA_LOAD_ROW
#undef NA_WRITE_ROW
#pragma unroll
                for (int qbi = 0; qbi < 2; ++qbi) { const int qb = 2 * qp + qbi; float lt = lrun[qbi]; lt += __shfl_xor(lt, 16); lt += __shfl_xor(lt, 32); const float il = 1.0f / lt;
                    bf16_t* dst = act + (tok0 + r * 64 + 16 * qb + q16) * ACT_LD + h * 64 + ((g4 & 1) ? 16 + 4 * (g4 - 1) : 4 * g4);
#pragma unroll
                    for (int dp = 0; dp < 2; ++dp) { const f32x4 oa = O[qbi][2 * dp] * il, ob = O[qbi][2 * dp + 1] * il;
                        const auto rx = __builtin_amdgcn_permlane16_swap(cvt_pk_bf16(oa[0], oa[1]), cvt_pk_bf16(ob[0], ob[1]), false, false);
                        const auto ry = __builtin_amdgcn_permlane16_swap(cvt_pk_bf16(oa[2], oa[3]), cvt_pk_bf16(ob[2], ob[3]), false, false);
                        u32x4 w; w.x = rx[0]; w.y = ry[0]; w.z = rx[1]; w.w = ry[1];
                        *(u32x4*)(dst + dp * 32) = w; } }
            }
            __syncthreads();
        }
#endif
#ifndef NO_FFT
        for (int rm_ = 0; rm_ < ((DUP_MIX == 1) ? 2 : 1); ++rm_) {
            int lane_o = lane, tid_o = tid; asm volatile("" : "+v"(lane_o), "+v"(tid_o)); const int q16 = lane_o & 15, g4 = lane_o >> 4;
            constexpr int ZP = 272;
            LAS unsigned char* Zt = lds;
            LAS unsigned char* XI = lds + 69632;
            u32x4 xin[4];
#define FFT_UNIT(kq_, b_, cb_) do { b_ = (vb + (kq_) * G) >> 7; cb_ = (vb + (kq_) * G) & 127; if (al) { b_ = xq >> 1; cb_ = 64 * (xq & 1) + (kq_) * 32 + jq; } } while (0)
#define FFT_FETCH(b_, cb_) do { const bf16_t* sp_ = fuT + (size_t)((b_) * 128 + (cb_)) * 4096 * 4; _Pragma("unroll") for (int i = 0; i < 4; ++i) xin[i] = *(const u32x4*)(sp_ + (size_t)(i * 512 + tid_o) * 8); } while (0)
            { int b0_, cb0_; FFT_UNIT(0, b0_, cb0_); if (vb < BATCH * 128) FFT_FETCH(b0_, cb0_); }
            for (int un = vb, kq = 0; un < BATCH * 128; un += G, ++kq) {
                int b, cb; FFT_UNIT(kq, b, cb);
                asm volatile("s_waitcnt lgkmcnt(0)" ::: "memory"); __builtin_amdgcn_s_barrier(); asm volatile("" ::: "memory");
#pragma unroll
                for (int i = 0; i < 4; ++i) *(LAS u32x4*)(XI + (i * 512 + tid_o) * 16) = xin[i];
                asm volatile("s_waitcnt lgkmcnt(0)" ::: "memory"); __builtin_amdgcn_s_barrier(); asm volatile("" ::: "memory");
#pragma unroll 1
                for (int ngi = 0; ngi < 2; ++ngi) {
                    const int ng = 2 * wave + ngi, sa = 4 * ng + (q16 >> 2), c = q16 & 3;
                    const LAS unsigned char* xp = XI + (sa + 512 * g4) * 8 + c * 2;
                    bf16x8 bfr[2];
#pragma unroll
                    for (int ks = 0; ks < 2; ++ks)
#pragma unroll
                        for (int j = 0; j < 8; ++j) bfr[ks][j] = *(const LAS short*)(xp + (64 * (ks * 32 + j)) * 8);
                    f32x4 acc[8];
#pragma unroll
                    for (int mb = 0; mb < 8; ++mb) { acc[mb] = (f32x4){0.f, 0.f, 0.f, 0.f};
#pragma unroll
                        for (int ks = 0; ks < 2; ++ks) { const bf16x8 af = *(const bf16x8*)(D1f + ((mb * 2 + ks) * 64 + lane_o) * 8); acc[mb] = MFMA16(af, bfr[ks], acc[mb]); } }
#pragma unroll
                    for (int t = 0; t < 4; ++t)
#pragma unroll
                        for (int e = 0; e < 4; ++e) { const int kb = 16 * t + 4 * g4 + e; const float rev = (float)(kb * sa) * (1.0f / 4096.0f);
                            const float ct = cosrev(rev), st = sinrev(rev), zr = acc[2 * t][e], zi = acc[2 * t + 1][e];
                            *(LAS unsigned*)(Zt + (kb * 4 + c) * ZP + sa * 4) = cvt_pk_bf16(zr * ct + zi * st, zi * ct - zr * st); }
                }
                if (un + G < BATCH * 128) { int b2_, cb2_; FFT_UNIT(kq + 1, b2_, cb2_); FFT_FETCH(b2_, cb2_); }
                asm volatile("s_waitcnt lgkmcnt(0)" ::: "memory"); __builtin_amdgcn_s_barrier(); asm volatile("" ::: "memory");
                {
                    const int mb = wave; bf16x8 af[4];
#pragma unroll
                    for (int ks = 0; ks < 4; ++ks) af[ks] = *(const bf16x8*)(D2f + ((mb * 4 + ks) * 64 + lane_o) * 8);
                    LAS unsigned char* OUTI = lds + 69632;
#pragma unroll 4
                    for (int nb = 0; nb < 16; ++nb) {
                        f32x4 a2 = (f32x4){0.f, 0.f, 0.f, 0.f};
#pragma unroll
                        for (int ks = 0; ks < 4; ++ks) { const bf16x8 bfg = *(const LAS bf16x8*)(Zt + (nb * 16 + q16) * ZP + ks * 64 + g4 * 16); a2 = MFMA16(af[ks], bfg, a2); }
                        const int kb = 4 * nb + (q16 >> 2), c = q16 & 3, ka0 = 8 * mb + 2 * g4;
                        *(LAS unsigned*)(OUTI + (64 * ka0 + kb) * 16 + c * 4) = cvt_pk_bf16(a2[0] * (1.0f / 64.0f), a2[1] * (1.0f / 64.0f));
                        *(LAS unsigned*)(OUTI + (64 * (ka0 + 1) + kb) * 16 + c * 4) = cvt_pk_bf16(a2[2] * (1.0f / 64.0f), a2[3] * (1.0f / 64.0f));
                    }
                    asm volatile("s_waitcnt lgkmcnt(0)" ::: "memory"); __builtin_amdgcn_s_barrier(); asm volatile("" ::: "memory");
                    bf16_t* dstp = pimg + ((size_t)(b * 128 + cb) * 4096) * 8;
#pragma unroll
                    for (int i = 0; i < 8; ++i) { const int id = i * 512 + tid_o; *(u32x4*)(dstp + (size_t)id * 8) = *(const LAS u32x4*)(OUTI + id * 16); }
                }
            }
            __syncthreads();
        }
#undef FFT_UNIT
#undef FFT_FETCH
#endif
#ifndef NO_CROSS
        for (int rm_ = 0; rm_ < ((DUP_MIX == 2) ? 2 : 1); ++rm_) {
            int lane_o = lane, tid_o = tid; asm volatile("" : "+v"(lane_o), "+v"(tid_o)); const int q16 = lane_o & 15, g4 = lane_o >> 4;
            constexpr int KP = 272;
            LAS unsigned char* Ks = lds; LAS unsigned char* Vm = lds + 69632; LAS float* rsk = (LAS float*)(lds + 139264);
            for (int un = vb; un < BATCH * 4 * 16; un += G) {
                int b = un >> 6, hm = (un >> 4) & 3, qt = un & 15;
                if (al) { const int pmq = 8 * xq + (jq >> 2); b = pmq >> 4; qt = pmq & 15; hm = jq & 3; }
                __syncthreads();
#pragma unroll
                for (int i = 0; i < 8; ++i) { const int id = i * 512 + tid_o, row = id >> 4, ch = id & 15;

#ifdef EXP_KV_FROM_MEMN
                    const bf16_t* src = memn + ((size_t)b * MEMT + row) * D + hm * 128 + ch * 8;
#else
                    const bf16_t* src = memkv + ((size_t)b * MEMT + row) * D + hm * 128 + ch * 8;
#endif

                    const u32x4 kv = *(const u32x4*)src; const u32x4 vv = *(const u32x4*)(src + 512);
                    float s = 0.f, t;
                    t = bf_lo(kv.x); s += t * t; t = bf_hi(kv.x); s += t * t; t = bf_lo(kv.y); s += t * t; t = bf_hi(kv.y); s += t * t;
                    t = bf_lo(kv.z); s += t * t; t = bf_hi(kv.z); s += t * t; t = bf_lo(kv.w); s += t * t; t = bf_hi(kv.w); s += t * t;
                    s += __shfl_xor(s, 1); s += __shfl_xor(s, 2); s += __shfl_xor(s, 4); s += __shfl_xor(s, 8);
                    if (ch == 0) rsk[row] = rsqrtf(s * (1.0f / 128.0f) + EPS);
                    *(LAS u32x4*)(Ks + row * KP + ch * 16) = kv; *(LAS u32x4*)(Vm + row * KP + ch * 16) = vv; }
                __syncthreads();
#pragma unroll 1
                for (int qbi = 0; qbi < 2; ++qbi) {
                    const size_t tok = (size_t)b * SEQ + qt * 256 + wave * 32 + qbi * 16 + q16;
                    const bf16_t* src = zbuf + tok * NZ + OFF_MQ + hm * 128;
                    bf16x8 qf[4];
                    { u32x4 raw[4]; float s = 0.f;
#pragma unroll
                      for (int ks = 0; ks < 4; ++ks) { raw[ks] = *(const u32x4*)(src + ks * 32 + 8 * g4); float t;
                          t = bf_lo(raw[ks].x); s += t * t; t = bf_hi(raw[ks].x); s += t * t; t = bf_lo(raw[ks].y); s += t * t; t = bf_hi(raw[ks].y); s += t * t;
                          t = bf_lo(raw[ks].z); s += t * t; t = bf_hi(raw[ks].z); s += t * t; t = bf_lo(raw[ks].w); s += t * t; t = bf_hi(raw[ks].w); s += t * t; }
                      s += __shfl_xor(s, 16); s += __shfl_xor(s, 32);
                      const float rq = rsqrtf(s * (1.0f / 128.0f) + EPS) * 0.08838834764831845f;
#pragma unroll
                      for (int ks = 0; ks < 4; ++ks) { const int d0 = ks * 32 + 8 * g4; float gg[8];
#pragma unroll
                          for (int j = 0; j < 8; ++j) gg[j] = p.mem_q_g[d0 + j] * p.mem_k_g[d0 + j] * rq;
                          u32x4 w; w.x = cvt_pk_bf16(bf_lo(raw[ks].x) * gg[0], bf_hi(raw[ks].x) * gg[1]); w.y = cvt_pk_bf16(bf_lo(raw[ks].y) * gg[2], bf_hi(raw[ks].y) * gg[3]);
                          w.z = cvt_pk_bf16(bf_lo(raw[ks].z) * gg[4], bf_hi(raw[ks].z) * gg[5]); w.w = cvt_pk_bf16(bf_lo(raw[ks].w) * gg[6], bf_hi(raw[ks].w) * gg[7]);
                          qf[ks] = __builtin_bit_cast(bf16x8, w); } }
                    f32x4 S[16];
#pragma unroll
                    for (int kb = 0; kb < 16; ++kb) { S[kb] = (f32x4){0.f, 0.f, 0.f, 0.f};
#pragma unroll
                        for (int ks = 0; ks < 4; ++ks) { const bf16x8 kf = *(const LAS bf16x8*)(Ks + (kb * 16 + q16) * KP + ks * 64 + g4 * 16); S[kb] = MFMA16(kf, qf[ks], S[kb]); }
                        const f32x4 rk4 = *(const LAS f32x4*)(rsk + kb * 16 + 4 * g4); S[kb] *= rk4; __builtin_amdgcn_sched_barrier(0); }
                    float mx = -1e30f;
#pragma unroll
                    for (int kb = 0; kb < 16; ++kb) mx = fmaxf(mx, fmaxf(fmaxf(S[kb][0], S[kb][1]), fmaxf(S[kb][2], S[kb][3])));
                    mx = fmaxf(mx, __shfl_xor(mx, 16)); mx = fmaxf(mx, __shfl_xor(mx, 32));
                    float ps = 0.f;
#pragma unroll
                    for (int kb = 0; kb < 16; ++kb)
#pragma unroll
                        for (int e = 0; e < 4; ++e) { S[kb][e] = __expf(S[kb][e] - mx); ps += S[kb][e]; }
                    ps += __shfl_xor(ps, 16); ps += __shfl_xor(ps, 32);
                    const float il = 1.0f / ps;
                    f32x4 Oa[8];
#pragma unroll
                    for (int db = 0; db < 8; ++db) Oa[db] = (f32x4){0.f, 0.f, 0.f, 0.f};
#pragma unroll
                    for (int kp = 0; kp < 8; ++kp) {
                        u32x4 pw; pw.x = cvt_pk_bf16(S[2 * kp][0], S[2 * kp][1]); pw.y = cvt_pk_bf16(S[2 * kp][2], S[2 * kp][3]); pw.z = cvt_pk_bf16(S[2 * kp + 1][0], S[2 * kp + 1][1]); pw.w = cvt_pk_bf16(S[2 * kp + 1][2], S[2 * kp + 1][3]);
                        const bf16x8 pf = __builtin_bit_cast(bf16x8, pw);
#pragma unroll
                        for (int db = 0; db < 8; ++db) {
                            bf16x8 vf;
#if USE_TR
                            { const int qq = q16 >> 2, pp = q16 & 3;
                              const s16x4 lo4 = __builtin_amdgcn_ds_read_tr16_b64_v4i16((LAS s16x4*)(Vm + (32 * kp + 4 * g4 + qq) * KP + (db * 16 + 4 * pp) * 2));
                              const s16x4 hi4 = __builtin_amdgcn_ds_read_tr16_b64_v4i16((LAS s16x4*)(Vm + (32 * kp + 16 + 4 * g4 + qq) * KP + (db * 16 + 4 * pp) * 2));
                              vf = __builtin_shufflevector(lo4, hi4, 0, 1, 2, 3, 4, 5, 6, 7); }
#else
#pragma unroll
                            for (int j = 0; j < 8; ++j) { const int key = 32 * kp + ((j < 4) ? 0 : 16) + 4 * g4 + (j & 3); vf[j] = *(LAS short*)(Vm + key * KP + (db * 16 + q16) * 2); }
#endif
                            Oa[db] = MFMA16(vf, pf, Oa[db]);
                        }
                        __builtin_amdgcn_sched_barrier(0);
                    }
                    { const rsrc_t ars = mk_rsrc(act);
                      const unsigned o0 = (unsigned)((tok * ACT_LD + 1536 + hm * 128 + ((g4 & 1) ? 16 + 4 * (g4 - 1) : 4 * g4)) * 2);
#pragma unroll
                      for (int dp = 0; dp < 4; ++dp) { const f32x4 oa = Oa[2 * dp] * il, ob = Oa[2 * dp + 1] * il;
                          const auto rx = __builtin_amdgcn_permlane16_swap(cvt_pk_bf16(oa[0], oa[1]), cvt_pk_bf16(ob[0], ob[1]), false, false);
                          const auto ry = __builtin_amdgcn_permlane16_swap(cvt_pk_bf16(oa[2], oa[3]), cvt_pk_bf16(ob[2], ob[3]), false, false);
                          u32x4 w; w.x = rx[0]; w.y = ry[0]; w.z = rx[1]; w.w = ry[1];
                          st16_wt(ars, o0 + dp * 64, w); } }
                }
            }
            __syncthreads();
        }
#endif
    }
    if (BOTH(2)) GRID_SYNC();

    if (IN(3)) for (int rep_ = 0; rep_ < NREP(3); ++rep_) {
        if (rep_) GRID_SYNC();
#ifdef EXP_BRANCH
        constexpr int eoff = (EXP_BRANCH == 0) ? 0 : (EXP_BRANCH == 1) ? 512 : 1536, ek = (EXP_BRANCH == 1) ? 1024 : 512;
        pg8::Gemm g{act + eoff, Wcat + eoff, act, Wcat, ACT_LD, 2048, ek, nullptr, 128, 128};
#else
        pg8::Gemm g{act, Wcat, act, Wcat, ACT_LD, 2048, 2048, pimg, 128, 128};
#endif
        pg8::StaticOrder S; S.init(M, D, G, bid);
        pg8::EpiMerge E{gbuf, merged};
        pg8::gemm_phase<pg8::EpiMerge, pg8::StaticOrder, false, true>(lds, g, S, E);
    }
    if (BOTH(3)) GRID_SYNC();

    if (IN(4)) for (int rep_ = 0; rep_ < NREP(4); ++rep_) {
        if (rep_) GRID_SYNC();
        pg8::Gemm g{merged, WoutT, merged, WoutT, D, D, D, nullptr, 128, 128};
        pg8::StaticOrder S; S.init(M, D, G, bid);
        pg8::EpiWout E{p.x, xmb, ssq, (LAS float*)(lds + 131072)};
        pg8::gemm_phase<pg8::EpiWout, pg8::StaticOrder, true>(lds, g, S, E);
    }
    if (BOTH(4)) GRID_SYNC();

    if (IN(5)) for (int rep_ = 0; rep_ < NREP(5); ++rep_) {
        if (rep_) GRID_SYNC();
        pg8::Gemm g{xmb, W1T, xmb, W1T, D, D, D, nullptr, 128, 128};
        pg8::StaticOrder S; S.init(M, FF, G, bid);
        { volatile LAS int* cpm = (volatile LAS int*)(lds + 131072 + 1024); if (tid == 0) *cpm = -1; __syncthreads(); }
        pg8::EpiFfn1 E{ssq, abuf, (LAS float*)(lds + 131072)};
        pg8::gemm_phase<pg8::EpiFfn1, pg8::StaticOrder, true>(lds, g, S, E);
    }
    if (BOTH(5)) GRID_SYNC();

    if (IN(6)) for (int rep_ = 0; rep_ < NREP(6); ++rep_) {
        if (rep_) GRID_SYNC();
        pg8::Gemm g{abuf, W2T, abuf, W2T, 64, 64, FF, nullptr, (size_t)M * 128, (size_t)D * 128};
        pg8::StaticOrder S; S.init(M, D, G, bid);
        pg8::EpiFfn2 E{xmb, p.out};
        pg8::gemm_phase<pg8::EpiFfn2, pg8::StaticOrder, false>(lds, g, S, E);
    }
#undef IN
#undef BOTH
}

extern "C" void kernel_launch(void* const* d_in, const int* in_sizes, int n_in, void* d_out, int out_size, void* d_ws, size_t ws_size, hipStream_t stream) {
    static int grid = 0;
    if (grid == 0) {
        if (n_in != 19 || out_size != M * D || ws_size < WS_END) { fprintf(stderr, "kernel_launch: unexpected shapes (n_in %d out %d ws %zu)\n", n_in, out_size, ws_size); grid = -1; return; }
        int dev = 0, cus = 0, per_cu = 0;
        hipGetDevice(&dev); hipDeviceGetAttribute(&cus, hipDeviceAttributeMultiprocessorCount, dev);
        hipFuncSetAttribute((const void*)fwd_kernel, hipFuncAttributeMaxDynamicSharedMemorySize, LDS_BYTES);
        hipOccupancyMaxActiveBlocksPerMultiprocessor(&per_cu, (const void*)fwd_kernel, 512, LDS_BYTES);
        if (per_cu < 1) { fprintf(stderr, "kernel_launch: occupancy query says %d blocks/CU\n", per_cu); per_cu = 1; }
        (void)hipGetLastError();
        grid = cus * per_cu;
    }
    if (grid < 0) return;
    Params p{};
    p.x = (const float*)d_in[0]; p.mem = (const float*)d_in[1]; p.norm1_g = (const float*)d_in[2]; p.w_in = (const float*)d_in[3]; p.b_gate = (const float*)d_in[4];
    p.na_q_g = (const float*)d_in[5]; p.na_k_g = (const float*)d_in[6]; p.na_rpb = (const float*)d_in[7]; p.w_na_o = (const float*)d_in[8]; p.w_f = (const float*)d_in[9];
    p.mem_norm_g = (const float*)d_in[10]; p.w_mem_kv = (const float*)d_in[11]; p.mem_q_g = (const float*)d_in[12]; p.mem_k_g = (const float*)d_in[13]; p.w_mem_o = (const float*)d_in[14];
    p.w_out = (const float*)d_in[15]; p.norm2_g = (const float*)d_in[16]; p.w_ff1 = (const float*)d_in[17]; p.w_ff2 = (const float*)d_in[18];
    p.out = (float*)d_out; p.ws = (unsigned char*)d_ws;
#if MK_N_LAUNCHES == 1
    (void)hipMemsetAsync((char*)d_ws + WS_BAR, 0, XCD_BAR_WORDS * 4, stream);
    p.ph_lo = 0; p.ph_hi = 7;
    void* args[] = {&p};
    hipError_t e = hipLaunchCooperativeKernel((const void*)fwd_kernel, dim3(grid), dim3(512), args, LDS_BYTES, stream);
    if (e != hipSuccess) fprintf(stderr, "cooperative launch failed: %s (grid %d)\n", hipGetErrorString(e), grid);
#else
    for (int ph = 0; ph < 7; ++ph) { p.ph_lo = ph; p.ph_hi = ph + 1; hipLaunchKernelGGL(fwd_kernel, dim3(grid), dim3(512), LDS_BYTES, stream, p); }
#endif
}
```
